# Optimizing an MI355X kernel written in HIP

```python
import jax, jax.numpy as jnp
from jax import lax
import numpy as np

D_MODEL = 2048
BATCH = 2
SEQ = 8192
DEPTH = 1

HEAD_DIM = 64
ATT_WIDTH = 1024
RWKV_WIDTH = 1024
MIX_WIDTH = ATT_WIDTH + RWKV_WIDTH
N_ATT_HEADS = ATT_WIDTH // HEAD_DIM
N_RWKV_HEADS = RWKV_WIDTH // HEAD_DIM
DIL_PATTERNS = ((128, 1), (512, 4), (2048, 16))
ATT_BLOCK = 128
ROPE_THETA = 10000.0
DECAY_LORA = 64
AAA_LORA = 64
GATE_LORA = 160
NORM_EPS = 1e-5
LNX_EPS = 64e-5
SHIFT_WIDTH = 3 * RWKV_WIDTH + DECAY_LORA + AAA_LORA + GATE_LORA
IN_WIDTH = 4 * ATT_WIDTH + SHIFT_WIDTH + RWKV_WIDTH

kernel_name = 'hymba_rwkv7_dilated_attention_hybrid'


def rms_norm(x, g):
    xf = x.astype(jnp.float32)
    y = xf * lax.rsqrt(jnp.mean(xf * xf, axis=-1, keepdims=True) + NORM_EPS)
    return (y * g.astype(jnp.float32)).astype(x.dtype)


def apply_rope(t, pos):
    inv_freq = ROPE_THETA ** (-jnp.arange(0, HEAD_DIM, 2, dtype=jnp.float32) / HEAD_DIM)
    ang = pos.astype(jnp.float32)[:, None] * inv_freq[None, :]
    cos = jnp.cos(ang)[None, :, None, :]
    sin = jnp.sin(ang)[None, :, None, :]
    t = t.astype(jnp.float32)
    t1, t2 = t[..., : HEAD_DIM // 2], t[..., HEAD_DIM // 2:]
    return jnp.concatenate([t1 * cos - t2 * sin, t2 * cos + t1 * sin], axis=-1)


def dilated_window_attention(q, k, v, dilation, n_back):
    B, S, H, Dh = q.shape
    L = S // dilation
    nb = -(-L // ATT_BLOCK)
    Lp = nb * ATT_BLOCK

    def to_classes(t):
        t = t.reshape(B, L, dilation, H, Dh).transpose(0, 2, 3, 1, 4)
        return jnp.pad(t, ((0, 0), (0, 0), (0, 0), (0, Lp - L), (0, 0)))

    def windows(t):
        t = jnp.pad(t, ((0, 0), (0, 0), (0, 0), (ATT_BLOCK, 0), (0, 0)))
        t = t.reshape(B, dilation, H, nb + 1, ATT_BLOCK, Dh)
        return jnp.concatenate([t[:, :, :, :-1], t[:, :, :, 1:]], axis=4)

    qb = to_classes(q).reshape(B, dilation, H, nb, ATT_BLOCK, Dh)
    kw = windows(to_classes(k))
    vw = windows(to_classes(v))
    s = jnp.einsum('bdhnqc,bdhnkc->bdhnqk', qb, kw)
    qi = jnp.arange(ATT_BLOCK)[:, None]
    ki = jnp.arange(2 * ATT_BLOCK)[None, :]
    rel = ATT_BLOCK + qi - ki
    band = (rel >= 0) & (rel <= n_back)
    blk = jnp.arange(nb)[:, None, None]
    valid = band[None] & ((blk > 0) | (ki[None] >= ATT_BLOCK))
    s = jnp.where(valid, s, -jnp.inf)
    m = jnp.max(s, axis=-1, keepdims=True)
    p = jnp.exp(s - m)
    den = jnp.sum(p, axis=-1)
    o = jnp.einsum('bdhnqk,bdhnkc->bdhnqc', p, vw) / den[..., None]
    lse = m[..., 0] + jnp.log(den)
    o = o.reshape(B, dilation, H, Lp, Dh)[:, :, :, :L].transpose(0, 3, 1, 2, 4).reshape(B, S, H, Dh)
    lse = lse.reshape(B, dilation, H, Lp)[:, :, :, :L].transpose(0, 3, 1, 2).reshape(B, S, H)
    return o, lse


def dilated_mixture_attention(q, k, v, pos):
    B, S, _ = q.shape
    q = apply_rope(q.reshape(B, S, N_ATT_HEADS, HEAD_DIM), pos) * (HEAD_DIM ** -0.5)
    k = apply_rope(k.reshape(B, S, N_ATT_HEADS, HEAD_DIM), pos)
    v = v.reshape(B, S, N_ATT_HEADS, HEAD_DIM)
    outs, lses = [], []
    for window, dilation in DIL_PATTERNS:
        o, lse = dilated_window_attention(q, k, v, dilation, window // dilation)
        outs.append(o)
        lses.append(lse)
    wts = jax.nn.softmax(jnp.stack(lses), axis=0)
    o = jnp.einsum('pbsh,pbshc->bshc', wts, jnp.stack(outs))
    return o.reshape(B, S, ATT_WIDTH)


def rwkv7_recurrence(r, w, k, v, a, b):
    B, S, H, N = r.shape

    def step(state, inp):
        r_t, w_t, k_t, v_t, a_t, b_t = inp
        sa = jnp.einsum('bhij,bhj->bhi', state, a_t)
        state = (state * w_t[:, :, None, :] + sa[..., None] * b_t[:, :, None, :]
                 + v_t[..., None] * k_t[:, :, None, :])
        y = jnp.einsum('bhij,bhj->bhi', state, r_t)
        return state, y

    xs = tuple(t.transpose(1, 0, 2, 3) for t in (r, w, k, v, a, b))
    init = jnp.zeros((B, H, N, N), jnp.float32)
    _, y = lax.scan(step, init, xs)
    return y.transpose(1, 0, 2, 3)


def rwkv7_time_mix(u, z, mu, w0, w2, a0, a2, g2, k_k, k_a, r_k, lnx_g, lnx_b):
    B, S, _ = u.shape
    R = RWKV_WIDTH
    u_prev = jnp.pad(u, ((0, 0), (1, 0), (0, 0)))[:, :S]
    u = u + (u_prev - u) * mu
    r, k, v, wl, al, gl = jnp.split(
        u, [R, 2 * R, 3 * R, 3 * R + DECAY_LORA, 3 * R + DECAY_LORA + AAA_LORA], axis=-1)
    w_log = -jax.nn.softplus(-(w0 + jnp.matmul(jnp.tanh(wl), w2))) - 0.5
    decay = jnp.exp(-jnp.exp(w_log))
    a = jax.nn.sigmoid(a0 + jnp.matmul(al, a2))
    g = jnp.matmul(jax.nn.sigmoid(gl), g2)

    def heads(t):
        return t.reshape(B, S, N_RWKV_HEADS, HEAD_DIM)

    kk = heads(k * k_k)
    kk = kk / jnp.maximum(jnp.sqrt(jnp.sum(kk * kk, axis=-1, keepdims=True)), 1e-12)
    k = k * (1.0 + (a - 1.0) * k_a)
    rh, kh, vh, ah = heads(r), heads(k), heads(v), heads(a)
    y = rwkv7_recurrence(rh, heads(decay), kh, vh, -kk, kk * ah)
    mean = jnp.mean(y, axis=-1, keepdims=True)
    var = jnp.mean(jnp.square(y - mean), axis=-1, keepdims=True)
    y = ((y - mean) * lax.rsqrt(var + LNX_EPS)).reshape(B, S, R) * lnx_g + lnx_b
    bonus = (jnp.sum(rh * kh * r_k, axis=-1, keepdims=True) * vh).reshape(B, S, R)
    return (y + bonus) * g * jax.nn.silu(z)


def setup_inputs(seed: int = 0) -> dict:
    key = jax.random.key(seed)
    ks = jax.random.split(key, 16)
    f32 = jnp.float32
    R = RWKV_WIDTH
    x = jax.random.normal(ks[0], (BATCH, SEQ, D_MODEL), f32)
    norm_g = 1.0 + 0.02 * jax.random.normal(ks[1], (DEPTH, D_MODEL), f32)
    w_in = jax.random.normal(ks[2], (DEPTH, D_MODEL, IN_WIDTH), f32) * D_MODEL ** -0.5
    shift_mu = jax.random.uniform(ks[3], (DEPTH, SHIFT_WIDTH), f32)
    w0 = jnp.linspace(-6.0, -1.0, R, dtype=f32)[None, :] + 0.1 * jax.random.normal(ks[4], (DEPTH, R), f32)
    w2 = jax.random.normal(ks[5], (DEPTH, DECAY_LORA, R), f32) * (0.1 * DECAY_LORA ** -0.5)
    a0 = 0.1 * jax.random.normal(ks[6], (DEPTH, R), f32)
    a2 = jax.random.normal(ks[7], (DEPTH, AAA_LORA, R), f32) * (0.5 * AAA_LORA ** -0.5)
    g2 = jax.random.normal(ks[8], (DEPTH, GATE_LORA, R), f32) * GATE_LORA ** -0.5
    k_k = 0.85 + 0.02 * jax.random.normal(ks[9], (DEPTH, R), f32)
    k_a = 1.0 + 0.02 * jax.random.normal(ks[10], (DEPTH, R), f32)
    r_k = -0.04 + 0.05 * jax.random.normal(ks[11], (DEPTH, N_RWKV_HEADS, HEAD_DIM), f32)
    lnx_g = 1.0 + 0.02 * jax.random.normal(ks[12], (DEPTH, R), f32)
    lnx_b = 0.02 * jax.random.normal(ks[13], (DEPTH, R), f32)
    w_out = jax.random.normal(ks[14], (DEPTH, MIX_WIDTH, D_MODEL), f32) * MIX_WIDTH ** -0.5
    final_g = 1.0 + 0.02 * jax.random.normal(ks[15], (D_MODEL,), f32)
    return {'x': x, 'norm_g': norm_g, 'w_in': w_in, 'shift_mu': shift_mu, 'w0': w0,
            'w2': w2, 'a0': a0, 'a2': a2, 'g2': g2, 'k_k': k_k, 'k_a': k_a, 'r_k': r_k,
            'lnx_g': lnx_g, 'lnx_b': lnx_b, 'w_out': w_out, 'final_g': final_g}


def reference(x, norm_g, w_in, shift_mu, w0, w2, a0, a2, g2, k_k, k_a, r_k,
              lnx_g, lnx_b, w_out, final_g):
    B, S, _ = x.shape
    pos = jnp.arange(S, dtype=jnp.int32)
    A = ATT_WIDTH
    splits = [A, 2 * A, 3 * A, 4 * A, 4 * A + SHIFT_WIDTH]
    for l in range(DEPTH):
        h = rms_norm(x, norm_g[l])
        proj = jnp.matmul(h, w_in[l]).astype(jnp.float32)
        q, k, v, z_att, u_shift, z_rwkv = jnp.split(proj, splits, axis=-1)
        att = dilated_mixture_attention(q, k, v, pos) * jax.nn.silu(z_att)
        rwk = rwkv7_time_mix(u_shift, z_rwkv, shift_mu[l], w0[l], w2[l], a0[l], a2[l],
                             g2[l], k_k[l], k_a[l], r_k[l], lnx_g[l], lnx_b[l])
        mix = jnp.concatenate([att, rwk], axis=-1).astype(x.dtype)
        x = x + jnp.matmul(mix, w_out[l])
    return rms_norm(x, final_g)
```

```cpp
#include <hip/hip_runtime.h>
#include <cstdio>
#include <cstdint>
namespace pg8 {
#define PG8_LAS __attribute__((address_space(3)))
typedef unsigned short bf16_t;
typedef short bf16x8 __attribute__((ext_vector_type(8)));
typedef float f32x4 __attribute__((ext_vector_type(4)));
typedef unsigned u32x4 __attribute__((ext_vector_type(4)));
constexpr int BM = 256, BK = 64, HALF = 128, HTB = HALF * BK * 2  , STAGE_BYTES = 8 * HTB, NXCD = 8, WGM = 8;

__host__ __device__ __forceinline__ int lds_byte(int r, int c) { const int st = (r >> 4) * 2 + (c >> 5), rr = r & 15, cc = c & 31, ob = rr * 64 + cc * 2; return st * 1024 + (ob ^ (((ob >> 9) & 1) << 5)); }
__host__ __device__ __forceinline__ void stage_rc(int b, int& R, int& C) { const int st = b / 1024, sb = b % 1024, swz = sb ^ (((sb >> 9) & 1) << 5); R = (st >> 1) * 16 + swz / 64; C = (st & 1) * 32 + (swz % 64) / 2; }
__host__ __device__ __forceinline__ int perm32(int rho) { const int n = rho >> 4, i = rho & 15; return 8 * (i >> 2) + 4 * n + (i & 3); }

struct Unit { int pm, pn; };
struct Gemm { const bf16_t* A; const bf16_t* Bt; int M, N, K; };

struct StaticOrder {
    int nM, nN, nwg, G, c;
    __host__ __device__ void init(int M, int N, int G_, int c_) { nM = M / BM; nN = N / BM; nwg = nM * nN; G = G_; c = c_; }
    __host__ __device__ bool next(int i, Unit& u) const {
        const long L = (long)i * G + c; if (L >= nwg) return false;
        int wgid = (int)L; { const int q = nwg / NXCD, r = nwg % NXCD, xcd = wgid % NXCD, off = wgid / NXCD; wgid = (xcd < r ? xcd * (q + 1) : r * (q + 1) + (xcd - r) * q) + off; }
        const int nig = WGM * nN, gid = wgid / nig, fm = gid * WGM, gsz = (nM - fm) < WGM ? (nM - fm) : WGM;
        u.pm = fm + ((wgid % nig) % gsz); u.pn = (wgid % nig) / gsz; return true;
    }
    __device__ __forceinline__ void a_ready(const Unit&) const {}
    __device__ __forceinline__ void done(const Unit&) const {}
};

__device__ __forceinline__ unsigned cvt_pk_bf16(float lo, float hi) { unsigned r; asm volatile("v_cvt_pk_bf16_f32 %0, %1, %2" : "=v"(r) : "v"(lo), "v"(hi)); return r; }
typedef float f32x2 __attribute__((ext_vector_type(2)));
__device__ __forceinline__ f32x2 gelu_pk(f32x2 v) {
    const f32x2 av = __builtin_elementwise_abs(v), d = av * 0.2316418882f + 1.0f;
    f32x2 t; t.x = __builtin_amdgcn_rcpf(d.x); t.y = __builtin_amdgcn_rcpf(d.y);
    f32x2 q = t * 0.5307027145f + (-0.7265760135f); q = q * t + 0.7107068705f; q = q * t + (-0.142248368f); q = q * t + 0.127414796f; q = q * t;
    const f32x2 s = (v * v) * (-0.72134752044f);
    f32x2 e; e.x = __builtin_amdgcn_exp2f(s.x); e.y = __builtin_amdgcn_exp2f(s.y);
    const f32x2 m = v * (q * e), r = v - m;
    f32x2 o; o.x = v.x < 0.f ? m.x : r.x; o.y = v.y < 0.f ? m.y : r.y; return o;
}

template <int ACT  > struct EpiBf16 {
    static constexpr bool PERM = true, AFTER_DRAIN = false; static_assert(ACT == 0 || ACT == 1, "EpiBf16: ACT is 0 (none) or 1 (gelu_pk)");
    bf16_t* O; int ldc; const float* bias; int split_cols; size_t split_stride; float scale0;
    __device__ __forceinline__ void operator()(const f32x4 (&acc)[2][2][4][2], const Unit& u, int wr, int wc, int fr, int fq) const {
        const int row0 = u.pm * BM + wr * 64 + fr; int colt = u.pn * BM; bf16_t* base = O;
        float sc = 1.f; if (split_cols) { const int t = colt / split_cols; base += (size_t)t * split_stride; colt -= t * split_cols; if (t == 0) sc = scale0; }
        const int col0 = colt + wc * 32 + 8 * fq, bcol0 = u.pn * BM + wc * 32 + 8 * fq;
        f32x4 bv[2][2];
#pragma unroll
        for (int bj = 0; bj < 2; ++bj)
#pragma unroll
            for (int n = 0; n < 2; ++n) bv[bj][n] = bias ? *(const f32x4*)(bias + bcol0 + bj * HALF + 4 * n) : (f32x4){0.f, 0.f, 0.f, 0.f};
#pragma unroll
        for (int ai = 0; ai < 2; ++ai)
#pragma unroll
            for (int m = 0; m < 4; ++m) { bf16_t* rowp = base + (size_t)(row0 + ai * HALF + m * 16) * ldc + col0;
#pragma unroll
                for (int bj = 0; bj < 2; ++bj) { f32x4 v0 = acc[ai][bj][m][0] + bv[bj][0], v1 = acc[ai][bj][m][1] + bv[bj][1];
                    if (ACT == 1) { f32x2 a = gelu_pk((f32x2){v0[0], v0[1]}), b = gelu_pk((f32x2){v0[2], v0[3]}), c = gelu_pk((f32x2){v1[0], v1[1]}), d = gelu_pk((f32x2){v1[2], v1[3]});
                        v0 = (f32x4){a.x, a.y, b.x, b.y}; v1 = (f32x4){c.x, c.y, d.x, d.y}; }
                    v0 = v0 * sc; v1 = v1 * sc; u32x4 w; w.x = cvt_pk_bf16(v0[0], v0[1]); w.y = cvt_pk_bf16(v0[2], v0[3]); w.z = cvt_pk_bf16(v1[0], v1[1]); w.w = cvt_pk_bf16(v1[2], v1[3]);
                    *(u32x4*)(rowp + bj * HALF) = w; } }
    }
};


template <class Epi, class Sched, bool ALIGN_EPI = false, bool SP2 = false>
__device__ __forceinline__ void gemm_phase(PG8_LAS unsigned char* lds, const Gemm g, const Sched& S, const Epi& E) {
    const int tid = threadIdx.x, wid = __builtin_amdgcn_readfirstlane(tid >> 6), lane = tid & 63, wr = wid >> 2, wc = wid & 3, fr = lane & 15, fq = lane >> 4;
    const int K = g.K, nt = K / BK;
    unsigned voffA[2], voffB[2];
#pragma unroll
    for (int i = 0; i < 2; ++i) { int R, C; stage_rc(tid * 16 + i * 8192, R, C); const int Rb = Epi::PERM ? ((R & ~31) + perm32(R & 31)) : R;
        voffA[i] = (unsigned)(R * K + C) * 2u; voffB[i] = (unsigned)(Rb * K + C) * 2u; }
    const size_t kstep = (size_t)(BK * 2);
    const size_t hstep = (size_t)HALF * K * 2;
    const size_t tstep = 2 * hstep;
    const unsigned ldsw = (unsigned)wid * 1024u;
    const int aoff = lds_byte(wr * 64 + fr, fq * 8), boff = lds_byte(wc * 32 + fr, fq * 8);
#define PG8_SA(b, h) (((b) * 2 + (h)) * HTB)
#define PG8_SB(b, h) ((4 + (b) * 2 + (h)) * HTB)
#define PG8_STAGE(bufoff, gbase, voff) do { _Pragma("unroll") for (int _i = 0; _i < 2; ++_i) \
        __builtin_amdgcn_global_load_lds((const unsigned*)((const char*)(gbase) + (voff)[_i]), (PG8_LAS unsigned*)(lds + (bufoff) + ldsw + _i * 8192), 16, 0, 0); } while (0)
#define PG8_LDA(dst, b, h) do { _Pragma("unroll") for (int m = 0; m < 4; ++m) _Pragma("unroll") for (int k = 0; k < 2; ++k) dst[m][k] = *(const PG8_LAS bf16x8*)(lds + PG8_SA(b, h) + aoff + m * 2048 + k * 1024); } while (0)
#define PG8_LDB(dst, b, h) do { _Pragma("unroll") for (int n = 0; n < 2; ++n) _Pragma("unroll") for (int k = 0; k < 2; ++k) dst[n][k] = *(const PG8_LAS bf16x8*)(lds + PG8_SB(b, h) + boff + n * 2048 + k * 1024); } while (0)
#define PG8_MMA(ai, bj, At, Bt) do { __builtin_amdgcn_s_setprio(1); _Pragma("unroll") for (int m = 0; m < 4; ++m) _Pragma("unroll") for (int n = 0; n < 2; ++n) _Pragma("unroll") for (int k = 0; k < 2; ++k) \
        acc[ai][bj][m][n] = __builtin_amdgcn_mfma_f32_16x16x32_bf16(Bt[n][k], At[m][k], acc[ai][bj][m][n], 0, 0, 0); __builtin_amdgcn_s_setprio(0); } while (0)
#define PG8_WAIT_V(n) asm volatile("s_waitcnt vmcnt(" #n ")" ::: "memory")
#define PG8_WAIT_L(n) asm volatile("s_waitcnt lgkmcnt(" #n ")" ::: "memory")
#define PG8_BAR __builtin_amdgcn_s_barrier()
#define PG8_SCHED __builtin_amdgcn_sched_barrier(0)
    Unit cur, nxt; int ui = 0;
    if (!S.next(0, cur)) return;
    f32x4 acc[2][2][4][2];
#pragma unroll
    for (int a = 0; a < 2; ++a)
#pragma unroll
        for (int b = 0; b < 2; ++b)
#pragma unroll
            for (int m = 0; m < 4; ++m)
#pragma unroll
                for (int n = 0; n < 2; ++n) acc[a][b][m][n] = (f32x4){0.f, 0.f, 0.f, 0.f};
    bf16x8 At[4][2], B0[2][2], B1[2][2];
    const char* cA = (const char*)g.A + (size_t)cur.pm * tstep; const char* cB = (const char*)g.Bt + (size_t)cur.pn * tstep;
    S.a_ready(cur);
    if constexpr (SP2) {
        PG8_STAGE(PG8_SB(0, 0), cB, voffB); PG8_STAGE(PG8_SB(0, 1), cB + hstep, voffB); PG8_STAGE(PG8_SA(0, 0), cA, voffA); PG8_STAGE(PG8_SA(0, 1), cA + hstep, voffA);
        if (wr == 1) PG8_BAR;
        PG8_WAIT_V(2); PG8_BAR;
        PG8_STAGE(PG8_SB(1, 0), cB + kstep, voffB); PG8_STAGE(PG8_SA(1, 0), cA + kstep, voffA); PG8_STAGE(PG8_SB(1, 1), cB + hstep + kstep, voffB);
        PG8_WAIT_V(6); PG8_BAR;
    } else {
        PG8_STAGE(PG8_SB(0, 0), cB, voffB); PG8_STAGE(PG8_SA(0, 0), cA, voffA); PG8_STAGE(PG8_SB(0, 1), cB + hstep, voffB); PG8_STAGE(PG8_SA(0, 1), cA + hstep, voffA);
        if (wr == 1) PG8_BAR;
        PG8_WAIT_V(4); PG8_BAR;
        PG8_STAGE(PG8_SB(1, 0), cB + kstep, voffB); PG8_STAGE(PG8_SA(1, 0), cA + kstep, voffA); PG8_STAGE(PG8_SB(1, 1), cB + hstep + kstep, voffB);
        PG8_WAIT_V(6); PG8_BAR;
    }
    for (;;) {
        const bool has_next = S.next(ui + 1, nxt);
        const char* nA = has_next ? (const char*)g.A + (size_t)nxt.pm * tstep : cA; const char* nB = has_next ? (const char*)g.Bt + (size_t)nxt.pn * tstep : cB;
        for (int t = 0; t < nt; t += 2) {
            const bool last = (t == nt - 2);
            const char* a1 = cA + (size_t)(t + 1) * kstep;
            const char* a2 = last ? nA : cA + (size_t)(t + 2) * kstep; const char* b2 = last ? nB : cB + (size_t)(t + 2) * kstep;
            const char* a3 = a2 + kstep; const char* b3 = b2 + kstep;
            if (last && has_next) S.a_ready(nxt);
            if constexpr (SP2) {
            PG8_LDB(B0, 0, 0); PG8_LDB(B1, 0, 1); PG8_SCHED; PG8_LDA(At, 0, 0); PG8_STAGE(PG8_SA(1, 1), a1 + hstep, voffA);
            PG8_WAIT_V(8); PG8_WAIT_L(0); PG8_BAR; PG8_MMA(0, 0, At, B0); PG8_MMA(0, 1, At, B1); PG8_BAR; PG8_SCHED;
            PG8_LDA(At, 0, 1); PG8_STAGE(PG8_SB(0, 0), b2, voffB); PG8_STAGE(PG8_SB(0, 1), b2 + hstep, voffB); PG8_STAGE(PG8_SA(0, 0), a2, voffA);
            PG8_WAIT_V(8); PG8_WAIT_L(0); PG8_BAR; PG8_MMA(1, 0, At, B0); PG8_MMA(1, 1, At, B1); PG8_BAR; PG8_SCHED;
            PG8_LDB(B0, 1, 0); PG8_LDB(B1, 1, 1); PG8_SCHED; PG8_LDA(At, 1, 0); PG8_STAGE(PG8_SA(0, 1), a2 + hstep, voffA);
            PG8_WAIT_V(8); PG8_WAIT_L(0); PG8_BAR; PG8_MMA(0, 0, At, B0); PG8_MMA(0, 1, At, B1); PG8_BAR; PG8_SCHED;
            PG8_LDA(At, 1, 1); PG8_STAGE(PG8_SB(1, 0), b3, voffB); PG8_STAGE(PG8_SB(1, 1), b3 + hstep, voffB); PG8_STAGE(PG8_SA(1, 0), a3, voffA);
            PG8_WAIT_V(8); PG8_WAIT_L(0); PG8_BAR; PG8_MMA(1, 0, At, B0); PG8_MMA(1, 1, At, B1); PG8_BAR; PG8_SCHED;
            } else {
            PG8_LDB(B0, 0, 0); PG8_SCHED; PG8_LDA(At, 0, 0); PG8_STAGE(PG8_SA(1, 1), a1 + hstep, voffA);
            PG8_WAIT_L(8); PG8_BAR; PG8_WAIT_L(0); PG8_MMA(0, 0, At, B0); PG8_BAR; PG8_SCHED;
            PG8_LDB(B1, 0, 1); PG8_STAGE(PG8_SB(0, 0), b2, voffB);
            PG8_BAR; PG8_WAIT_L(0); PG8_MMA(0, 1, At, B1); PG8_BAR;
            PG8_LDA(At, 0, 1); PG8_STAGE(PG8_SA(0, 0), a2, voffA);
            PG8_BAR; PG8_WAIT_L(0); PG8_MMA(1, 0, At, B0); PG8_BAR; PG8_SCHED;
            PG8_STAGE(PG8_SB(0, 1), b2 + hstep, voffB);
            PG8_WAIT_V(6); PG8_BAR; PG8_MMA(1, 1, At, B1); PG8_BAR;
            PG8_LDB(B0, 1, 0); PG8_SCHED; PG8_LDA(At, 1, 0); PG8_STAGE(PG8_SA(0, 1), a2 + hstep, voffA);
            PG8_WAIT_L(8); PG8_BAR; PG8_WAIT_L(0); PG8_MMA(0, 0, At, B0); PG8_BAR; PG8_SCHED;
            PG8_LDB(B1, 1, 1); PG8_STAGE(PG8_SB(1, 0), b3, voffB);
            PG8_BAR; PG8_WAIT_L(0); PG8_MMA(0, 1, At, B1); PG8_BAR;
            PG8_LDA(At, 1, 1); PG8_STAGE(PG8_SA(1, 0), a3, voffA);
            PG8_BAR; PG8_WAIT_L(0); PG8_MMA(1, 0, At, B0); PG8_BAR; PG8_SCHED;
            PG8_STAGE(PG8_SB(1, 1), b3 + hstep, voffB);
            PG8_WAIT_V(6); PG8_BAR; PG8_MMA(1, 1, At, B1); PG8_BAR;
            }
        }
        if constexpr (ALIGN_EPI) { if (wr == 0) PG8_BAR; }
        if constexpr (!Epi::AFTER_DRAIN) { E(acc, cur, wr, wc, fr, fq); S.done(cur); }
        if (!has_next) break;
#pragma unroll
        for (int a = 0; a < 2; ++a)
#pragma unroll
            for (int b = 0; b < 2; ++b)
#pragma unroll
                for (int m = 0; m < 4; ++m)
#pragma unroll
                    for (int n = 0; n < 2; ++n) acc[a][b][m][n] = (f32x4){0.f, 0.f, 0.f, 0.f};
        cur = nxt; cA = nA; cB = nB; ++ui;
        if constexpr (ALIGN_EPI) { if (wr == 1) PG8_BAR; }
    }
    PG8_WAIT_V(0);
    if constexpr (!ALIGN_EPI) { if (wr == 0) PG8_BAR; }
    PG8_BAR;
    if constexpr (Epi::AFTER_DRAIN) { E.fused(acc, cur, wr, wc, fr, fq, lds, wid, lane); S.done(cur); }
#undef PG8_SA
#undef PG8_SB
#undef PG8_STAGE
#undef PG8_LDA
#undef PG8_LDB
#undef PG8_MMA
#undef PG8_WAIT_V
#undef PG8_WAIT_L
#undef PG8_BAR
#undef PG8_SCHED
}
}
#define GAS __attribute__((address_space(1)))
#define LAS __attribute__((address_space(3)))
typedef unsigned short bf16;
typedef unsigned v4u __attribute__((ext_vector_type(4)));
typedef float f32x4 __attribute__((ext_vector_type(4)));
typedef short bf16x8 __attribute__((ext_vector_type(8)));
typedef GAS unsigned gu32;
typedef GAS unsigned long long gu64;
#define RLX_AGENT __ATOMIC_RELAXED, __HIP_MEMORY_SCOPE_AGENT
#define LDS_WAIT() asm volatile("s_waitcnt lgkmcnt(0)" ::: "memory")
#define VM_WAIT() asm volatile("s_waitcnt vmcnt(0)" ::: "memory")
__device__ __forceinline__ unsigned long long rt() { return __builtin_amdgcn_s_memrealtime(); }
__device__ __forceinline__ unsigned f2bf(float f) { unsigned u = __builtin_bit_cast(unsigned, f); return (u + 0x7fffu + ((u >> 16) & 1u)) >> 16; }
__device__ __forceinline__ unsigned pk2(float lo, float hi) { return f2bf(lo) | (f2bf(hi) << 16); }

#define XB_TMO      128
#define XB_XCNT(j)  (256  + 64 * (j))
#define XB_XSUB(j)  (1280 + 64 * (j))
#define XB_XGEN(j)  (2304 + 64 * (j))
#define XB_TOP      3328
#define XB_TOPGEN   3392
#define XCD_BAR_WORDS 3456
#define XB_SPIN_CAP (1u << 18)

__device__ __forceinline__ unsigned xb_ld(unsigned* p)              { return __hip_atomic_load(p, __ATOMIC_RELAXED, __HIP_MEMORY_SCOPE_AGENT); }
__device__ __forceinline__ unsigned xb_add(unsigned* p, unsigned v) { return __hip_atomic_fetch_add(p, v, __ATOMIC_RELAXED, __HIP_MEMORY_SCOPE_AGENT); }
__device__ __forceinline__ unsigned xb_xcc_id() { return (unsigned)__builtin_amdgcn_s_getreg((3 << 11) | 20) & 0xFu; }
#define XB_SPIN(cond, bar) do { unsigned _sp = 0; while (cond) { __builtin_amdgcn_s_sleep(1); \
    if ((++_sp & 255u) == 0u) { if (xb_ld(&(bar)[XB_TMO])) break; if (_sp > XB_SPIN_CAP) { atomicAdd(&(bar)[XB_TMO], 1u); break; } } } } while (0)

struct XcdBarrier {
    unsigned* bar; unsigned x;
    volatile LAS unsigned* st;
};

__device__ __forceinline__ XcdBarrier xcd_barrier_post(unsigned* bar, volatile LAS unsigned* st) {
    XcdBarrier b; b.bar = bar; b.x = xb_xcc_id(); b.st = st;
    if (threadIdx.x == 0) (void)xb_add(&bar[XB_XCNT(b.x)], 1u);
    return b;
}
__device__ __forceinline__ void xcd_barrier_complete(unsigned* bar, unsigned x, unsigned& nloc, unsigned& nx) {
    const unsigned G = gridDim.x * gridDim.y * gridDim.z;
    unsigned sum, cnt, mine, sp = 0u;
    for (;;) {
        sum = 0u; cnt = 0u; mine = 0u;
#pragma unroll
        for (unsigned j = 0; j < 16; ++j) { const unsigned c = xb_ld(&bar[XB_XCNT(j)]); sum += c; cnt += (c > 0u) ? 1u : 0u; mine = (j == x) ? c : mine; }
        if (sum == G) break;
        __builtin_amdgcn_s_sleep(1);
        if ((++sp & 255u) == 0u) { if (xb_ld(&bar[XB_TMO])) break; if (sp > XB_SPIN_CAP) { atomicAdd(&bar[XB_TMO], 1u); break; } }
    }
    nloc = mine > 0u ? mine : 1u; nx = cnt > 0u ? cnt : 1u;
}

__device__ __forceinline__ void xcd_barrier(const XcdBarrier& b) {
    asm volatile("s_waitcnt vmcnt(0)" ::: "memory");
    __syncthreads();
    if (threadIdx.x == 0) {
        unsigned* bar = b.bar;
        __builtin_amdgcn_s_waitcnt(0);
        unsigned nloc = b.st[0], nx = b.st[1];
        if (nloc == 0u) { xcd_barrier_complete(bar, b.x, nloc, nx); b.st[0] = nloc; b.st[1] = nx; }
        const unsigned old = xb_add(&bar[XB_XSUB(b.x)], 1u);
        const unsigned gen = old / nloc;
        if (old + 1u == (gen + 1u) * nloc) {
            __builtin_amdgcn_fence(__ATOMIC_RELEASE, "agent");
            asm volatile("s_waitcnt vmcnt(0)" ::: "memory");
            const unsigned og = xb_add(&bar[XB_TOP], 1u);
            const unsigned tg = og / nx;
            if (og + 1u == (tg + 1u) * nx) xb_add(&bar[XB_TOPGEN], 1u);
            else XB_SPIN(xb_ld(&bar[XB_TOPGEN]) == tg, bar);
            __builtin_amdgcn_fence(__ATOMIC_ACQUIRE, "agent");
            xb_add(&bar[XB_XGEN(b.x)], 1u);
            asm volatile("s_waitcnt vmcnt(0)" ::: "memory");
        } else {
            XB_SPIN(xb_ld(&bar[XB_XGEN(b.x)]) == gen, bar);
            __builtin_amdgcn_fence(__ATOMIC_ACQUIRE, "agent");
            asm volatile("s_waitcnt vmcnt(0)" ::: "memory");
        }
    }
    __syncthreads();
}

constexpr int NWAVES = 8;
#ifndef MK_N_LAUNCHES
#define MK_N_LAUNCHES 8
#endif
constexpr int NPHASE = 8;
constexpr int N_LAUNCHES = MK_N_LAUNCHES;

constexpr int BATCH = 2, SEQ = 8192, DM = 2048, M = BATCH * SEQ, NH = 16, HD = 64;
constexpr int N1 = 8704, IN_W = 8480, NLORA = 3072, KLORA = 384;
constexpr float NORM_EPS = 1e-5f, LNX_EPS = 64e-5f;
constexpr float C2Q = 0.125f * 1.4426950408889634f;

constexpr size_t MiB = 1u << 20;
constexpr size_t WS_CTL = 0, CTL_ZERO_BYTES = 1 * MiB;
constexpr size_t WS_SSQ = 1 * MiB;
constexpr size_t WS_COS = 2 * MiB, WS_SIN = 3 * MiB;
constexpr size_t WS_BTL = 4 * MiB;
constexpr size_t WS_BT2 = 8 * MiB;
constexpr size_t WS_BT1 = 16 * MiB;
constexpr size_t WS_XN = 50 * MiB;
constexpr size_t WS_OP = 16 * MiB;
constexpr size_t WS_XL = 16 * MiB;
constexpr size_t WS_SA = 114 * MiB;
constexpr size_t WS_SB = 242 * MiB;
constexpr size_t WS_SC = 338 * MiB;
constexpr size_t WS_SD = 370 * MiB;
constexpr size_t WS_MIX = 386 * MiB;
constexpr size_t WS_AL = 450 * MiB;
constexpr size_t WS_LSE = 462 * MiB;
constexpr size_t WS_END = 512 * MiB;
constexpr int CW_BAR = 4096;

constexpr int RING_BYTES = 131072, LDSCTL_OFF = RING_BYTES, MISC_OFF = LDSCTL_OFF + 320, LDS_BYTES = 147456;

typedef float f32x16 __attribute__((ext_vector_type(16)));
typedef short s16x4 __attribute__((ext_vector_type(4)));
typedef unsigned u32x2 __attribute__((ext_vector_type(2)));

__device__ __forceinline__ float wave_sum(float v) {
#pragma unroll
    for (int o = 1; o < 64; o <<= 1) v += __shfl_xor(v, o);
    return v;
}
__device__ __forceinline__ float bf2f(unsigned short b) { return __builtin_bit_cast(float, (unsigned)b << 16); }
__device__ __forceinline__ float bflo(unsigned w) { return __builtin_bit_cast(float, w << 16); }
__device__ __forceinline__ float bfhi(unsigned w) { return __builtin_bit_cast(float, w & 0xffff0000u); }
__device__ __forceinline__ float sigmoidf_(float x) { return __builtin_amdgcn_rcpf(1.0f + __expf(-x)); }
__device__ __forceinline__ float siluf_(float x) { return x * sigmoidf_(x); }
__device__ __forceinline__ void unpack8(const v4u w, float (&f)[8]) {
    f[0] = bflo(w.x); f[1] = bfhi(w.x); f[2] = bflo(w.y); f[3] = bfhi(w.y); f[4] = bflo(w.z); f[5] = bfhi(w.z); f[6] = bflo(w.w); f[7] = bfhi(w.w);
}
__device__ __forceinline__ v4u pack8(const float (&f)[8]) { v4u w; w.x = pk2(f[0], f[1]); w.y = pk2(f[2], f[3]); w.z = pk2(f[4], f[5]); w.w = pk2(f[6], f[7]); return w; }
__device__ __forceinline__ float red8(float x) {
    x += __builtin_bit_cast(float, __builtin_amdgcn_update_dpp(0, __builtin_bit_cast(int, x), 0x141, 0xf, 0xf, true));
    x += __builtin_bit_cast(float, __builtin_amdgcn_update_dpp(0, __builtin_bit_cast(int, x), 0xB1, 0xf, 0xf, true));
    x += __builtin_bit_cast(float, __builtin_amdgcn_update_dpp(0, __builtin_bit_cast(int, x), 0x4E, 0xf, 0xf, true));
    return x;
}

struct Frame {
    LAS unsigned char* lds;
    int tid, lane, wave, vcu, G;
    const float *x, *norm_g, *w_in, *shift_mu, *w0, *w2, *a0, *a2, *g2, *k_k, *k_a, *r_k, *lnx_g, *lnx_b, *w_out, *final_g;
    float* out; unsigned char* ws;
};

__device__ __forceinline__ int gemm1_row_of_col(int o) {
    if (o < 2048) { const int d = o & 63, base = o - d; return base + (d < 32 ? 8 * (d >> 2) + (d & 3) : 8 * ((d - 32) >> 2) + 4 + (d & 3)); }
    if (o < 7168) return o;
    if (o < 7456) return o + 1024;
    return o - 288;
}
template <bool MAP>
__device__ __forceinline__ void transpose_item(const float* W, int K, int N, bf16* WT, LAS float* scr, int item, int lane) {
    const int nblk = N / 32, kb = item / nblk, nb = item % nblk, k0 = 64 * kb, n0 = 32 * nb;
#pragma unroll 8
    for (int i = 0; i < 32; ++i) { const int kk = 2 * i + (lane >> 5); scr[kk * 33 + (lane & 31)] = W[(size_t)(k0 + kk) * N + n0 + (lane & 31)]; }
    LDS_WAIT(); asm volatile("" ::: "memory");
    const int c = lane & 7;
#pragma unroll
    for (int j = 0; j < 4; ++j) { const int n = (lane >> 3) + 8 * j; const LAS float* s = scr + (8 * c) * 33 + n;
        v4u o; o.x = pk2(s[0 * 33], s[1 * 33]); o.y = pk2(s[2 * 33], s[3 * 33]); o.z = pk2(s[4 * 33], s[5 * 33]); o.w = pk2(s[6 * 33], s[7 * 33]);
        const int row = MAP ? gemm1_row_of_col(n0 + n) : (n0 + n);
        *(GAS v4u*)(WT + (size_t)row * K + k0 + 8 * c) = o; }
    LDS_WAIT(); asm volatile("" ::: "memory");
}
__device__ __forceinline__ void rms_row_to_bf16(const float* xrow, const float* g, bf16* orow, int lane) {
    const GAS f32x4* xr = (const GAS f32x4*)xrow + lane; const GAS f32x4* gr = (const GAS f32x4*)g + lane;
    f32x4 v[8]; float s = 0.f;
#pragma unroll
    for (int j = 0; j < 8; ++j) { v[j] = xr[64 * j]; s += (v[j].x * v[j].x + v[j].y * v[j].y) + (v[j].z * v[j].z + v[j].w * v[j].w); }
    const float rs = 1.0f / sqrtf(wave_sum(s) * (1.0f / DM) + NORM_EPS);
    GAS u32x2* o8 = (GAS u32x2*)orow + lane;
#pragma unroll
    for (int j = 0; j < 8; ++j) { const f32x4 gv = gr[64 * j]; u32x2 w; w.x = pk2(v[j].x * rs * gv.x, v[j].y * rs * gv.y); w.y = pk2(v[j].z * rs * gv.z, v[j].w * rs * gv.w); o8[64 * j] = w; }
}
__device__ __forceinline__ void p0_prologue(Frame& F) {
    LAS float* scr = (LAS float*)(F.lds + F.wave * 16384);
    const int gw = F.vcu * NWAVES + F.wave, NGW = F.G * NWAVES;
    const int gt = gw * 64 + F.lane, NGT = NGW * 64;
    bf16* BT1 = (bf16*)(F.ws + WS_BT1); bf16* BT2 = (bf16*)(F.ws + WS_BT2); bf16* BTL = (bf16*)(F.ws + WS_BTL); bf16* XN = (bf16*)(F.ws + WS_XN);
    constexpr int I_1 = (DM / 64) * (IN_W / 32), I_2 = (DM / 64) * (DM / 32);
    for (int it = gw; it < I_1 + I_2; it += NGW) {
        if (it < I_1) transpose_item<true>(F.w_in, DM, IN_W, BT1, scr, it, F.lane);
        else transpose_item<false>(F.w_out, DM, DM, BT2, scr, it - I_1, F.lane);
    }
    for (int i = gt; i < (N1 - IN_W) * DM / 8; i += NGT) ((GAS v4u*)(BT1 + (size_t)IN_W * DM))[i] = (v4u){0u, 0u, 0u, 0u};
    for (int i = gt; i < KLORA * 1024; i += NGT) { const int k = i >> 10, ch = i & 1023;
        const float vw = (k < 64) ? F.w2[k * 1024 + ch] : 0.f, va = (k >= 64 && k < 128) ? F.a2[(k - 64) * 1024 + ch] : 0.f, vg = (k >= 128 && k < 288) ? F.g2[(k - 128) * 1024 + ch] : 0.f;
        BTL[(size_t)ch * KLORA + k] = (bf16)f2bf(vw); BTL[(size_t)(1024 + ch) * KLORA + k] = (bf16)f2bf(va); BTL[(size_t)(2048 + ch) * KLORA + k] = (bf16)f2bf(vg); }
    { float* ct = (float*)(F.ws + WS_COS); float* st = (float*)(F.ws + WS_SIN);
      for (int i = gt; i < SEQ * 32; i += NGT) { const int pos = i >> 5, fi = i & 31;
          const double rev = (double)pos * exp2(-(double)fi * (13.287712379549449 / 32.0)) * 0.15915494309189535;
          const float fr = (float)(rev - floor(rev));
          ct[i] = __builtin_amdgcn_cosf(fr); st[i] = __builtin_amdgcn_sinf(fr); } }
    { float* ssq = (float*)(F.ws + WS_SSQ); for (int i = gt; i < M; i += NGT) ssq[i] = 0.f; }
    for (int m = gw; m < M; m += NGW) rms_row_to_bf16(F.x + (size_t)m * DM, F.norm_g, XN + (size_t)m * DM, F.lane);
}

struct EpiProj {
    static constexpr bool PERM = true, AFTER_DRAIN = false;
    pg8::bf16_t *SA, *SB, *SC, *SD; const float* cosT; const float* sinT;
    __device__ __forceinline__ void operator()(const pg8::f32x4 (&acc)[2][2][4][2], const pg8::Unit& u, int wr, int wc, int fr, int fq) const {
        const int pn = u.pn; pg8::bf16_t* base; int ld, colt, kind;
        if (pn < 16) { base = SA; ld = 4096; colt = 256 * pn; kind = pn < 4 ? 0 : pn < 8 ? 1 : pn < 12 ? 2 : 3; }
        else if (pn < 28) { base = SB; ld = 3072; colt = 256 * (pn - 16); kind = 2; }
        else if (pn < 32) { base = SC; ld = 1024; colt = 256 * (pn - 28); kind = 3; }
        else { base = SD; ld = 512; colt = 256 * (pn - 32); kind = 2; }
        const int row0 = u.pm * 256 + wr * 64 + fr, col0 = colt + wc * 32 + 8 * fq, e4 = 4 * (4 * (wc & 1) + fq);
#pragma unroll
        for (int ai = 0; ai < 2; ++ai)
#pragma unroll
            for (int m = 0; m < 4; ++m) { const int row = row0 + ai * 128 + m * 16; pg8::bf16_t* rowp = base + (size_t)row * ld + col0;
                pg8::f32x4 cs = {1.f, 1.f, 1.f, 1.f}, sn = {0.f, 0.f, 0.f, 0.f};
                if (kind <= 1) { const int pos = row & (SEQ - 1); cs = *(const pg8::f32x4*)(cosT + pos * 32 + e4); sn = *(const pg8::f32x4*)(sinT + pos * 32 + e4); }
#pragma unroll
                for (int bj = 0; bj < 2; ++bj) { pg8::f32x4 v0 = acc[ai][bj][m][0], v1 = acc[ai][bj][m][1];
                    if (kind <= 1) { const pg8::f32x4 o0 = v0 * cs - v1 * sn, o1 = v1 * cs + v0 * sn; const float s = kind == 0 ? C2Q : 1.0f; v0 = o0 * s; v1 = o1 * s; }
                    else if (kind == 3) {
#pragma unroll
                        for (int i = 0; i < 4; ++i) { v0[i] = siluf_(v0[i]); v1[i] = siluf_(v1[i]); } }
                    pg8::u32x4 w; w.x = pg8::cvt_pk_bf16(v0[0], v0[1]); w.y = pg8::cvt_pk_bf16(v0[2], v0[3]); w.z = pg8::cvt_pk_bf16(v1[0], v1[1]); w.w = pg8::cvt_pk_bf16(v1[2], v1[3]);
                    *(pg8::u32x4*)(rowp + bj * 128) = w; } }
    }
};
struct EpiOut {
    static constexpr bool PERM = false, AFTER_DRAIN = false;
    const float* x; float* out; float* ssq;
    __device__ __forceinline__ void operator()(const pg8::f32x4 (&acc)[2][2][4][2], const pg8::Unit& u, int wr, int wc, int fr, int fq) const {
        const int row0 = u.pm * 256 + wr * 64 + fr, col0 = u.pn * 256 + wc * 32 + 4 * fq;
#pragma unroll
        for (int ai = 0; ai < 2; ++ai)
#pragma unroll
            for (int m = 0; m < 4; ++m) { const int row = row0 + ai * 128 + m * 16; const size_t off = (size_t)row * DM + col0; float s = 0.f;
#pragma unroll
                for (int bj = 0; bj < 2; ++bj)
#pragma unroll
                    for (int n = 0; n < 2; ++n) { const pg8::f32x4 y = *(const pg8::f32x4*)(x + off + bj * 128 + n * 16) + acc[ai][bj][m][n];
                        *(pg8::f32x4*)(out + off + bj * 128 + n * 16) = y; s += (y[0] * y[0] + y[1] * y[1]) + (y[2] * y[2] + y[3] * y[3]); }
                s += __shfl_xor(s, 16); s += __shfl_xor(s, 32);
                if (fq == 0) atomicAdd(ssq + row, s); }
    }
};

constexpr int ATT_VP = 192;
constexpr int ATT_WLDS = 32 * ATT_VP + 4096 + 256;
__device__ __forceinline__ int crow(int r, int hi) { return (r & 3) + 8 * (r >> 2) + 4 * hi; }
__device__ __forceinline__ s16x4 vtr(const LAS unsigned char* p) { return __builtin_bit_cast(s16x4, __builtin_amdgcn_ds_read_tr16_b64_v4i16((LAS s16x4*)p)); }

__device__ __forceinline__ void attn_item(const bf16* SA, int dil, int b, int h, int r, int m0, bf16* Op, float* Lp, LAS unsigned char* wl, int lane) {
    const int q32 = lane & 31, hi = lane >> 5;
    const size_t tokb = (size_t)b * SEQ;
    const bf16* qrow = SA + (tokb + (size_t)(m0 + q32) * dil + r) * 4096 + h * 64;
    bf16x8 qf[4];
#pragma unroll
    for (int s = 0; s < 4; ++s) qf[s] = *(const bf16x8*)(qrow + 16 * s + 8 * hi);
    const int tmin = m0 >= 128 ? 0 : (128 - m0) >> 5;
    f32x16 sc[5];
#pragma unroll
    for (int t = 0; t < 5; ++t) {
        if (t < tmin) {
#pragma unroll
            for (int i = 0; i < 16; ++i) sc[t][i] = -INFINITY;
        } else {
            const bf16* krow = SA + (tokb + (size_t)(m0 - 128 + 32 * t + q32) * dil + r) * 4096 + 1024 + h * 64;
            bf16x8 kf[4];
#pragma unroll
            for (int s = 0; s < 4; ++s) kf[s] = *(const bf16x8*)(krow + 16 * s + 8 * hi);
            f32x16 a = {};
#pragma unroll
            for (int s = 0; s < 4; ++s) a = __builtin_amdgcn_mfma_f32_32x32x16_bf16(kf[s], qf[s], a, 0, 0, 0);
            if (t == 0) {
#pragma unroll
                for (int i = 0; i < 16; ++i) if (crow(i, hi) < q32) a[i] = -INFINITY;
            }
            if (t == 4) {
#pragma unroll
                for (int i = 0; i < 16; ++i) if (crow(i, hi) > q32) a[i] = -INFINITY;
            }
            sc[t] = a;
        }
    }
    float mx = -INFINITY;
#pragma unroll
    for (int t = 0; t < 5; ++t)
#pragma unroll
        for (int i = 0; i < 16; ++i) mx = fmaxf(mx, sc[t][i]);
    mx = fmaxf(mx, __shfl_xor(mx, 32));
    float l = 0.f;
#pragma unroll
    for (int t = 0; t < 5; ++t)
#pragma unroll
        for (int i = 0; i < 16; ++i) { const float p = __builtin_amdgcn_exp2f(sc[t][i] - mx); sc[t][i] = p; l += p; }
    l += __shfl_xor(l, 32);
    LAS float* wsf = (LAS float*)(wl + 32 * ATT_VP + 4096);
    if (hi == 0) wsf[q32] = __builtin_amdgcn_rcpf(l);
    f32x16 o[2]; o[0] = f32x16{}; o[1] = f32x16{};
    const LAS unsigned char* vrd = wl + (4 * hi + ((lane & 15) >> 2)) * ATT_VP + ((lane >> 4) & 1) * 32 + (lane & 3) * 8;
#pragma unroll
    for (int t = 0; t < 5; ++t) {
        if (t >= tmin) {
#pragma unroll
            for (int i = 0; i < 4; ++i) { const int row = (lane >> 3) + 8 * i, ch = lane & 7;
                const v4u v = *(const GAS v4u*)(SA + (tokb + (size_t)(m0 - 128 + 32 * t + row) * dil + r) * 4096 + 2048 + h * 64 + ch * 8);
                *(LAS v4u*)(wl + row * ATT_VP + ch * 16) = v; }
            LDS_WAIT(); asm volatile("" ::: "memory");
#pragma unroll
            for (int s2 = 0; s2 < 2; ++s2) {
                v4u pw; pw.x = pk2(sc[t][8 * s2 + 0], sc[t][8 * s2 + 1]); pw.y = pk2(sc[t][8 * s2 + 2], sc[t][8 * s2 + 3]); pw.z = pk2(sc[t][8 * s2 + 4], sc[t][8 * s2 + 5]); pw.w = pk2(sc[t][8 * s2 + 6], sc[t][8 * s2 + 7]);
                const bf16x8 pa = __builtin_bit_cast(bf16x8, pw);
#pragma unroll
                for (int db = 0; db < 2; ++db) {
                    const s16x4 lo = vtr(vrd + (16 * s2) * ATT_VP + db * 64), hh = vtr(vrd + (16 * s2 + 8) * ATT_VP + db * 64);
                    const bf16x8 vb = {lo[0], lo[1], lo[2], lo[3], hh[0], hh[1], hh[2], hh[3]};
                    o[db] = __builtin_amdgcn_mfma_f32_32x32x16_bf16(pa, vb, o[db], 0, 0, 0);
                }
            }
            LDS_WAIT(); asm volatile("" ::: "memory");
        }
    }
    LAS bf16* stg = (LAS bf16*)(wl + 32 * ATT_VP);
#pragma unroll
    for (int i = 0; i < 16; ++i) { const int q = crow(i, hi); const float li = wsf[q];
        stg[q * 64 + q32] = (bf16)f2bf(o[0][i] * li); stg[q * 64 + 32 + q32] = (bf16)f2bf(o[1][i] * li); }
    LDS_WAIT(); asm volatile("" ::: "memory");
#pragma unroll
    for (int i = 0; i < 4; ++i) { const int row = i * 8 + (lane >> 3), ch = lane & 7; const v4u v = *(const LAS v4u*)(stg + row * 64 + ch * 8);
        *(GAS v4u*)(Op + (tokb + (size_t)(m0 + row) * dil + r) * 1024 + h * 64 + ch * 8) = v; }
    if (hi == 0) Lp[(tokb + (size_t)(m0 + q32) * dil + r) * 16 + h] = mx + __builtin_amdgcn_logf(l);
    LDS_WAIT(); asm volatile("" ::: "memory");
}
__device__ __forceinline__ void attn_phase(Frame& F) {
    const bf16* SA = (const bf16*)(F.ws + WS_SA);
    LAS unsigned char* wl = F.lds + F.wave * ATT_WLDS;
    const int gw = F.vcu * NWAVES + F.wave, NGW = F.G * NWAVES;
    for (int it = gw; it < 3 * 8192; it += NGW) {
        const int pat = it >> 13, rem = it & 8191, bh = rem >> 8, tile = rem & 255;
        const int dil = pat == 0 ? 1 : pat == 1 ? 4 : 16, tpc = 256 / dil;
        const int r = tile / tpc, m0 = 32 * (tile % tpc);
        attn_item(SA, dil, bh >> 4, bh & 15, r, m0, (bf16*)(F.ws + WS_OP) + (size_t)pat * M * 1024, (float*)(F.ws + WS_LSE) + (size_t)pat * M * 16, wl, F.lane);
    }
}
__device__ __forceinline__ void lora_act_phase(Frame& F) {
    const bf16* SD = (const bf16*)(F.ws + WS_SD); bf16* AL = (bf16*)(F.ws + WS_AL);
    const int gt = (F.vcu * NWAVES + F.wave) * 64 + F.lane, NGT = F.G * NWAVES * 64;
    for (int i = gt; i < M * (KLORA / 8); i += NGT) { const int m = i / (KLORA / 8), c8 = (i % (KLORA / 8)) * 8;
        v4u o = {0u, 0u, 0u, 0u};
        if (c8 < 288) {
            float cur[8], prv[8], f[8];
            unpack8(*(const GAS v4u*)(SD + (size_t)m * 512 + c8), cur);
            if ((m & (SEQ - 1)) != 0) unpack8(*(const GAS v4u*)(SD + (size_t)(m - 1) * 512 + c8), prv);
            else {
#pragma unroll
                for (int e = 0; e < 8; ++e) prv[e] = 0.f; }
#pragma unroll
            for (int e = 0; e < 8; ++e) { const float mu = F.shift_mu[3072 + c8 + e]; const float xs = cur[e] + (prv[e] - cur[e]) * mu;
                f[e] = c8 < 64 ? tanhf(xs) : c8 < 128 ? xs : sigmoidf_(xs); }
            o = pack8(f);
        }
        *(GAS v4u*)(AL + (size_t)m * KLORA + c8) = o; }
}
__device__ __forceinline__ void combine_phase(Frame& F) {
    const bf16* SA = (const bf16*)(F.ws + WS_SA); const bf16* OP = (const bf16*)(F.ws + WS_OP); const float* LS = (const float*)(F.ws + WS_LSE); bf16* MIX = (bf16*)(F.ws + WS_MIX);
    const int gt = (F.vcu * NWAVES + F.wave) * 64 + F.lane, NGT = F.G * NWAVES * 64;
    for (int i = gt; i < M * 128; i += NGT) { const int m = i >> 7, c8 = (i & 127) * 8, h = c8 >> 6;
        const float l0 = LS[(size_t)m * 16 + h], l1 = LS[(size_t)(M + m) * 16 + h], l2 = LS[(size_t)(2 * M + m) * 16 + h];
        const float mx = fmaxf(l0, fmaxf(l1, l2));
        float w0 = __builtin_amdgcn_exp2f(l0 - mx), w1 = __builtin_amdgcn_exp2f(l1 - mx), w2 = __builtin_amdgcn_exp2f(l2 - mx);
        const float inv = 1.0f / (w0 + w1 + w2); w0 *= inv; w1 *= inv; w2 *= inv;
        float a[8], bq[8], c[8], z[8], f[8];
        unpack8(*(const GAS v4u*)(OP + (size_t)m * 1024 + c8), a); unpack8(*(const GAS v4u*)(OP + (size_t)(M + m) * 1024 + c8), bq); unpack8(*(const GAS v4u*)(OP + (size_t)(2 * M + m) * 1024 + c8), c);
        unpack8(*(const GAS v4u*)(SA + (size_t)m * 4096 + 3072 + c8), z);
#pragma unroll
        for (int e = 0; e < 8; ++e) f[e] = (w0 * a[e] + w1 * bq[e] + w2 * c[e]) * z[e];
        *(GAS v4u*)(MIX + (size_t)m * 2048 + c8) = pack8(f); }
}
__device__ __forceinline__ void rwkv_seq_phase(Frame& F) {
    if (F.vcu >= BATCH * NH) return;
    const int b = F.vcu >> 4, h = F.vcu & 15, tid = F.tid;
    const bf16* SB = (const bf16*)(F.ws + WS_SB); const bf16* SC = (const bf16*)(F.ws + WS_SC); const bf16* XL = (const bf16*)(F.ws + WS_XL); bf16* MIX = (bf16*)(F.ws + WS_MIX);
    LAS float* LR = (LAS float*)F.lds; LAS float* LW = LR + 4096; LAS float* LK = LW + 4096; LAS float* LA = LK + 4096; LAS float* LB = LA + 4096; LAS float* LV = LB + 4096; LAS float* LY = LV + 4096;
    const int tok = tid >> 3, cg = tid & 7, ch0 = h * 64 + 8 * cg;
    float mu_r[8], mu_k[8], mu_v[8], w0v[8], a0v[8], kkv[8], kav[8], rkv[8], lg[8], lb[8];
#pragma unroll
    for (int e = 0; e < 8; ++e) { mu_r[e] = F.shift_mu[ch0 + e]; mu_k[e] = F.shift_mu[1024 + ch0 + e]; mu_v[e] = F.shift_mu[2048 + ch0 + e]; w0v[e] = F.w0[ch0 + e]; a0v[e] = F.a0[ch0 + e];
        kkv[e] = F.k_k[ch0 + e]; kav[e] = F.k_a[ch0 + e]; rkv[e] = F.r_k[ch0 + e]; lg[e] = F.lnx_g[ch0 + e]; lb[e] = F.lnx_b[ch0 + e]; }
    float st[8];
#pragma unroll
    for (int e = 0; e < 8; ++e) st[e] = 0.f;
    for (int c = 0; c < SEQ / 64; ++c) {
        const size_t m = (size_t)b * SEQ + c * 64 + tok;
        {
            float r[8], k[8], v[8], pr[8], pk[8], pv[8], xw[8], xa[8];
            unpack8(*(const GAS v4u*)(SB + m * 3072 + ch0), r); unpack8(*(const GAS v4u*)(SB + m * 3072 + 1024 + ch0), k); unpack8(*(const GAS v4u*)(SB + m * 3072 + 2048 + ch0), v);
            if (c * 64 + tok != 0) { unpack8(*(const GAS v4u*)(SB + (m - 1) * 3072 + ch0), pr); unpack8(*(const GAS v4u*)(SB + (m - 1) * 3072 + 1024 + ch0), pk); unpack8(*(const GAS v4u*)(SB + (m - 1) * 3072 + 2048 + ch0), pv); }
            else {
#pragma unroll
                for (int e = 0; e < 8; ++e) { pr[e] = 0.f; pk[e] = 0.f; pv[e] = 0.f; } }
            unpack8(*(const GAS v4u*)(XL + m * 3072 + ch0), xw); unpack8(*(const GAS v4u*)(XL + m * 3072 + 1024 + ch0), xa);
            float kk[8], ss = 0.f, as[8];
#pragma unroll
            for (int e = 0; e < 8; ++e) { r[e] += (pr[e] - r[e]) * mu_r[e]; k[e] += (pk[e] - k[e]) * mu_k[e]; v[e] += (pv[e] - v[e]) * mu_v[e];
                as[e] = sigmoidf_(a0v[e] + xa[e]); kk[e] = k[e] * kkv[e]; ss += kk[e] * kk[e]; }
            ss = red8(ss); const float inv = 1.0f / fmaxf(sqrtf(ss), 1e-12f);
#pragma unroll
            for (int e = 0; e < 8; ++e) { const float kn = kk[e] * inv; const int o = tok * 64 + 8 * cg + e;
                LR[o] = r[e]; LW[o] = __expf(-0.6065306597126334f * sigmoidf_(w0v[e] + xw[e])); LK[o] = k[e] * (1.0f + (as[e] - 1.0f) * kav[e]); LA[o] = -kn; LB[o] = kn * as[e]; LV[o] = v[e]; }
        }
        __syncthreads();
        {
            const int i = tid >> 3, jo = 8 * (tid & 7);
            for (int t = 0; t < 64; ++t) {
                const f32x4 a0 = *(const LAS f32x4*)(LA + t * 64 + jo), a1 = *(const LAS f32x4*)(LA + t * 64 + jo + 4);
                float sa = (st[0] * a0[0] + st[1] * a0[1]) + (st[2] * a0[2] + st[3] * a0[3]) + (st[4] * a1[0] + st[5] * a1[1]) + (st[6] * a1[2] + st[7] * a1[3]);
                sa = red8(sa);
                const f32x4 w0_ = *(const LAS f32x4*)(LW + t * 64 + jo), w1_ = *(const LAS f32x4*)(LW + t * 64 + jo + 4);
                const f32x4 b0 = *(const LAS f32x4*)(LB + t * 64 + jo), b1 = *(const LAS f32x4*)(LB + t * 64 + jo + 4);
                const f32x4 k0 = *(const LAS f32x4*)(LK + t * 64 + jo), k1 = *(const LAS f32x4*)(LK + t * 64 + jo + 4);
                const f32x4 r0 = *(const LAS f32x4*)(LR + t * 64 + jo), r1 = *(const LAS f32x4*)(LR + t * 64 + jo + 4);
                const float vi = LV[t * 64 + i];
#pragma unroll
                for (int e = 0; e < 4; ++e) { st[e] = st[e] * w0_[e] + sa * b0[e] + vi * k0[e]; st[4 + e] = st[4 + e] * w1_[e] + sa * b1[e] + vi * k1[e]; }
                float y = (st[0] * r0[0] + st[1] * r0[1]) + (st[2] * r0[2] + st[3] * r0[3]) + (st[4] * r1[0] + st[5] * r1[1]) + (st[6] * r1[2] + st[7] * r1[3]);
                y = red8(y);
                if ((tid & 7) == 0) LY[t * 64 + i] = y;
            }
        }
        __syncthreads();
        {
            float y[8], s = 0.f, q = 0.f, bon = 0.f, g[8], z[8], f[8];
#pragma unroll
            for (int e = 0; e < 8; ++e) { y[e] = LY[tok * 64 + 8 * cg + e]; s += y[e]; }
            const float mean = red8(s) * (1.0f / 64.0f);
#pragma unroll
            for (int e = 0; e < 8; ++e) { y[e] -= mean; q += y[e] * y[e]; bon += LR[tok * 64 + 8 * cg + e] * LK[tok * 64 + 8 * cg + e] * rkv[e]; }
            const float rstd = 1.0f / sqrtf(red8(q) * (1.0f / 64.0f) + LNX_EPS); bon = red8(bon);
            unpack8(*(const GAS v4u*)(XL + m * 3072 + 2048 + ch0), g); unpack8(*(const GAS v4u*)(SC + m * 1024 + ch0), z);
#pragma unroll
            for (int e = 0; e < 8; ++e) f[e] = (y[e] * rstd * lg[e] + lb[e] + bon * LV[tok * 64 + 8 * cg + e]) * g[e] * z[e];
            *(GAS v4u*)(MIX + m * 2048 + 1024 + ch0) = pack8(f);
        }
        __syncthreads();
    }
}
__device__ __forceinline__ void final_norm_phase(Frame& F) {
    const float* ssq = (const float*)(F.ws + WS_SSQ);
    const int gw = F.vcu * NWAVES + F.wave, NGW = F.G * NWAVES;
    for (int m = gw; m < M; m += NGW) {
        const float rs = 1.0f / sqrtf(ssq[m] * (1.0f / DM) + NORM_EPS);
        GAS f32x4* yr = (GAS f32x4*)(F.out + (size_t)m * DM) + F.lane; const GAS f32x4* gr = (const GAS f32x4*)F.final_g + F.lane;
#pragma unroll
        for (int j = 0; j < 8; ++j) { const f32x4 v = yr[64 * j], g = gr[64 * j]; yr[64 * j] = v * rs * g; }
    }
}

struct Args { const float* in[16]; float* out; unsigned char* ws; int ph_lo, ph_hi, li, pad; };
__global__ void __launch_bounds__(NWAVES * 64, 2) hymba_fwd(Args args) {
    extern __shared__ __attribute__((aligned(16))) unsigned char lds[];
    Frame F;
    F.lds = (LAS unsigned char*)lds;
    F.tid = threadIdx.x; F.lane = F.tid & 63; F.wave = __builtin_amdgcn_readfirstlane(F.tid >> 6);
    F.G = gridDim.x; { const int bx = blockIdx.x; F.vcu = (F.G % 8 == 0) ? (bx % 8) * (F.G / 8) + bx / 8 : bx; }
    F.x = args.in[0]; F.norm_g = args.in[1]; F.w_in = args.in[2]; F.shift_mu = args.in[3]; F.w0 = args.in[4]; F.w2 = args.in[5]; F.a0 = args.in[6]; F.a2 = args.in[7]; F.g2 = args.in[8];
    F.k_k = args.in[9]; F.k_a = args.in[10]; F.r_k = args.in[11]; F.lnx_g = args.in[12]; F.lnx_b = args.in[13]; F.w_out = args.in[14]; F.final_g = args.in[15];
    F.out = args.out; F.ws = args.ws;
    volatile LAS unsigned* MISC = (volatile LAS unsigned*)(F.lds + MISC_OFF);
    for (int u = F.tid; u < (LDS_BYTES - LDSCTL_OFF) / 4; u += NWAVES * 64) ((LAS unsigned*)(F.lds + LDSCTL_OFF))[u] = 0u;
    __syncthreads();
    gu32* ctl = (gu32*)(F.ws + WS_CTL);
    XcdBarrier bar; bar.bar = (unsigned*)(ctl + CW_BAR); bar.x = 0; bar.st = nullptr;
    if (N_LAUNCHES != NPHASE) bar = xcd_barrier_post((unsigned*)(ctl + CW_BAR) + args.li * XCD_BAR_WORDS, MISC + 8);
    const int lo = args.ph_lo, hi = args.ph_hi;
#ifndef PHMASK
#define PHMASK 0xff
#endif
#define IN(k) (((PHMASK >> (k)) & 1) && lo <= (k) && (k) < hi)
#define SEAM(k) do { if (IN(k) && IN((k) + 1)) xcd_barrier(bar); } while (0)
    if (IN(0)) { p0_prologue(F); } SEAM(0);
    if (IN(1)) {
        pg8::Gemm g{(const pg8::bf16_t*)(F.ws + WS_XN), (const pg8::bf16_t*)(F.ws + WS_BT1), M, N1, DM + args.pad}; pg8::StaticOrder S; S.init(M, N1, F.G, (int)blockIdx.x);
        EpiProj E{(pg8::bf16_t*)(F.ws + WS_SA), (pg8::bf16_t*)(F.ws + WS_SB), (pg8::bf16_t*)(F.ws + WS_SC), (pg8::bf16_t*)(F.ws + WS_SD), (const float*)(F.ws + WS_COS), (const float*)(F.ws + WS_SIN)};
        pg8::gemm_phase<EpiProj, pg8::StaticOrder, true, true>(F.lds, g, S, E);
    } SEAM(1);
    if (IN(2)) { attn_phase(F); lora_act_phase(F); } SEAM(2);
    if (IN(3)) { combine_phase(F); } SEAM(3);
    if (IN(4)) {
        pg8::Gemm g{(const pg8::bf16_t*)(F.ws + WS_AL), (const pg8::bf16_t*)(F.ws + WS_BTL), M, NLORA, KLORA + args.pad}; pg8::StaticOrder S; S.init(M, NLORA, F.G, (int)blockIdx.x);
        pg8::EpiBf16<0> E{(pg8::bf16_t*)(F.ws + WS_XL), NLORA, nullptr, 0, 0, 1.f};
        pg8::gemm_phase<pg8::EpiBf16<0>, pg8::StaticOrder, true, true>(F.lds, g, S, E);
    } SEAM(4);
    if (IN(5)) { rwkv_seq_phase(F); } SEAM(5);
    if (IN(6)) {
        pg8::Gemm g{(const pg8::bf16_t*)(F.ws + WS_MIX), (const pg8::bf16_t*)(F.ws + WS_BT2), M, DM, DM + args.pad}; pg8::StaticOrder S; S.init(M, DM, F.G, (int)blockIdx.x);
        EpiOut E{F.x, F.out, (float*)(F.ws + WS_SSQ)};
        pg8::gemm_phase<EpiOut, pg8::StaticOrder, true, true>(F.lds, g, S, E);
    } SEAM(6);
    if (IN(7)) { final_norm_phase(F); }
#undef IN
#undef SEAM
}

extern "C" void kernel_launch(void* const* d_in, const int* in_sizes, int n_in, void* d_out, int out_size, void* d_ws, size_t ws_size, hipStream_t stream) {
    static int grid = 0;
    if (grid == 0) {
        if (n_in != 16 || in_sizes[0] != M * DM || out_size != M * DM || ws_size < WS_END) { fprintf(stderr, "kernel_launch: unexpected shapes (n_in %d, in0 %d, out %d, ws %zu)\n", n_in, n_in > 0 ? in_sizes[0] : -1, out_size, ws_size); grid = -1; return; }
        int dev = 0, cus = 0, per_cu = 0;
        if (hipGetDevice(&dev) != hipSuccess || hipDeviceGetAttribute(&cus, hipDeviceAttributeMultiprocessorCount, dev) != hipSuccess) { grid = -1; return; }
        if (hipFuncSetAttribute((const void*)hymba_fwd, hipFuncAttributeMaxDynamicSharedMemorySize, LDS_BYTES) != hipSuccess) { grid = -1; return; }
        if (hipOccupancyMaxActiveBlocksPerMultiprocessor(&per_cu, (const void*)hymba_fwd, NWAVES * 64, LDS_BYTES) != hipSuccess || per_cu < 1) { fprintf(stderr, "kernel_launch: occupancy query says %d blocks per CU\n", per_cu); grid = -1; return; }
        (void)hipGetLastError();
        grid = cus;
    }
    if (grid < 0) return;
    if (hipMemsetAsync((char*)d_ws + WS_CTL, 0, CTL_ZERO_BYTES, stream) != hipSuccess) return;
    Args a{};
    for (int i = 0; i < 16; ++i) a.in[i] = (const float*)d_in[i];
    a.out = (float*)d_out; a.ws = (unsigned char*)d_ws;
    if (N_LAUNCHES == 1) { a.ph_lo = 0; a.ph_hi = NPHASE; a.li = 0; hipLaunchKernelGGL(hymba_fwd, dim3(grid), dim3(NWAVES * 64), LDS_BYTES, stream, a); }
    else for (int li = 0; li < NPHASE; ++li) { a.ph_lo = li; a.ph_hi = li + 1; a.li = 0; hipLaunchKernelGGL(hymba_fwd, dim3(grid), dim3(NWAVES * 64), LDS_BYTES, stream, a); }
}
```

```cpp
#include <hip/hip_runtime.h>
#include <cstdio>
#include <cstdint>
namespace pg8 {
#define PG8_LAS __attribute__((address_space(3)))
typedef unsigned short bf16_t;
typedef short bf16x8 __attribute__((ext_vector_type(8)));
typedef float f32x4 __attribute__((ext_vector_type(4)));
typedef unsigned u32x4 __attribute__((ext_vector_type(4)));
constexpr int BM = 256, BK = 64, HALF = 128, HTB = HALF * BK * 2  , STAGE_BYTES = 8 * HTB, NXCD = 8, WGM = 8;

__host__ __device__ __forceinline__ int lds_byte(int r, int c) { const int st = (r >> 4) * 2 + (c >> 5), rr = r & 15, cc = c & 31, ob = rr * 64 + cc * 2; return st * 1024 + (ob ^ (((ob >> 9) & 1) << 5)); }
__host__ __device__ __forceinline__ void stage_rc(int b, int& R, int& C) { const int st = b / 1024, sb = b % 1024, swz = sb ^ (((sb >> 9) & 1) << 5); R = (st >> 1) * 16 + swz / 64; C = (st & 1) * 32 + (swz % 64) / 2; }
__host__ __device__ __forceinline__ int perm32(int rho) { const int n = rho >> 4, i = rho & 15; return 8 * (i >> 2) + 4 * n + (i & 3); }

struct Unit { int pm, pn; };
struct Gemm { const bf16_t* A; const bf16_t* Bt; int M, N, K; };

struct StaticOrder {
    int nM, nN, nwg, G, c;
    __host__ __device__ void init(int M, int N, int G_, int c_) { nM = M / BM; nN = N / BM; nwg = nM * nN; G = G_; c = c_; }
    __host__ __device__ bool next(int i, Unit& u) const {
        const long L = (long)i * G + c; if (L >= nwg) return false;
        int wgid = (int)L; { const int q = nwg / NXCD, r = nwg % NXCD, xcd = wgid % NXCD, off = wgid / NXCD; wgid = (xcd < r ? xcd * (q + 1) : r * (q + 1) + (xcd - r) * q) + off; }
        const int nig = WGM * nN, gid = wgid / nig, fm = gid * WGM, gsz = (nM - fm) < WGM ? (nM - fm) : WGM;
        u.pm = fm + ((wgid % nig) % gsz); u.pn = (wgid % nig) / gsz; return true;
    }
    __device__ __forceinline__ void a_ready(const Unit&) const {}
    __device__ __forceinline__ void done(const Unit&) const {}
};

__device__ __forceinline__ unsigned cvt_pk_bf16(float lo, float hi) { unsigned r; asm volatile("v_cvt_pk_bf16_f32 %0, %1, %2" : "=v"(r) : "v"(lo), "v"(hi)); return r; }
typedef float f32x2 __attribute__((ext_vector_type(2)));
__device__ __forceinline__ f32x2 gelu_pk(f32x2 v) {
    const f32x2 av = __builtin_elementwise_abs(v), d = av * 0.2316418882f + 1.0f;
    f32x2 t; t.x = __builtin_amdgcn_rcpf(d.x); t.y = __builtin_amdgcn_rcpf(d.y);
    f32x2 q = t * 0.5307027145f + (-0.7265760135f); q = q * t + 0.7107068705f; q = q * t + (-0.142248368f); q = q * t + 0.127414796f; q = q * t;
    const f32x2 s = (v * v) * (-0.72134752044f);
    f32x2 e; e.x = __builtin_amdgcn_exp2f(s.x); e.y = __builtin_amdgcn_exp2f(s.y);
    const f32x2 m = v * (q * e), r = v - m;
    f32x2 o; o.x = v.x < 0.f ? m.x : r.x; o.y = v.y < 0.f ? m.y : r.y; return o;
}

template <int ACT  > struct EpiBf16 {
    static constexpr bool PERM = true, AFTER_DRAIN = false; static_assert(ACT == 0 || ACT == 1, "EpiBf16: ACT is 0 (none) or 1 (gelu_pk)");
    bf16_t* O; int ldc; const float* bias; int split_cols; size_t split_stride; float scale0;
    __device__ __forceinline__ void operator()(const f32x4 (&acc)[2][2][4][2], const Unit& u, int wr, int wc, int fr, int fq) const {
        const int row0 = u.pm * BM + wr * 64 + fr; int colt = u.pn * BM; bf16_t* base = O;
        float sc = 1.f; if (split_cols) { const int t = colt / split_cols; base += (size_t)t * split_stride; colt -= t * split_cols; if (t == 0) sc = scale0; }
        const int col0 = colt + wc * 32 + 8 * fq, bcol0 = u.pn * BM + wc * 32 + 8 * fq;
        f32x4 bv[2][2];
#pragma unroll
        for (int bj = 0; bj < 2; ++bj)
#pragma unroll
            for (int n = 0; n < 2; ++n) bv[bj][n] = bias ? *(const f32x4*)(bias + bcol0 + bj * HALF + 4 * n) : (f32x4){0.f, 0.f, 0.f, 0.f};
#pragma unroll
        for (int ai = 0; ai < 2; ++ai)
#pragma unroll
            for (int m = 0; m < 4; ++m) { bf16_t* rowp = base + (size_t)(row0 + ai * HALF + m * 16) * ldc + col0;
#pragma unroll
                for (int bj = 0; bj < 2; ++bj) { f32x4 v0 = acc[ai][bj][m][0] + bv[bj][0], v1 = acc[ai][bj][m][1] + bv[bj][1];
                    if (ACT == 1) { f32x2 a = gelu_pk((f32x2){v0[0], v0[1]}), b = gelu_pk((f32x2){v0[2], v0[3]}), c = gelu_pk((f32x2){v1[0], v1[1]}), d = gelu_pk((f32x2){v1[2], v1[3]});
                        v0 = (f32x4){a.x, a.y, b.x, b.y}; v1 = (f32x4){c.x, c.y, d.x, d.y}; }
                    v0 = v0 * sc; v1 = v1 * sc; u32x4 w; w.x = cvt_pk_bf16(v0[0], v0[1]); w.y = cvt_pk_bf16(v0[2], v0[3]); w.z = cvt_pk_bf16(v1[0], v1[1]); w.w = cvt_pk_bf16(v1[2], v1[3]);
                    *(u32x4*)(rowp + bj * HALF) = w; } }
    }
};


template <class Epi, class Sched, bool ALIGN_EPI = false, bool SP2 = false>
__device__ __forceinline__ void gemm_phase(PG8_LAS unsigned char* lds, const Gemm g, const Sched& S, const Epi& E) {
    const int tid = threadIdx.x, wid = __builtin_amdgcn_readfirstlane(tid >> 6), lane = tid & 63, wr = wid >> 2, wc = wid & 3, fr = lane & 15, fq = lane >> 4;
    const int K = g.K, nt = K / BK;
    unsigned voffA[2], voffB[2];
#pragma unroll
    for (int i = 0; i < 2; ++i) { int R, C; stage_rc(tid * 16 + i * 8192, R, C); const int Rb = Epi::PERM ? ((R & ~31) + perm32(R & 31)) : R;
        voffA[i] = (unsigned)(R * K + C) * 2u; voffB[i] = (unsigned)(Rb * K + C) * 2u; }
    const size_t kstep = (size_t)(BK * 2);
    const size_t hstep = (size_t)HALF * K * 2;
    const size_t tstep = 2 * hstep;
    const unsigned ldsw = (unsigned)wid * 1024u;
    const int aoff = lds_byte(wr * 64 + fr, fq * 8), boff = lds_byte(wc * 32 + fr, fq * 8);
#define PG8_SA(b, h) (((b) * 2 + (h)) * HTB)
#define PG8_SB(b, h) ((4 + (b) * 2 + (h)) * HTB)
#define PG8_STAGE(bufoff, gbase, voff) do { _Pragma("unroll") for (int _i = 0; _i < 2; ++_i) \
        __builtin_amdgcn_global_load_lds((const unsigned*)((const char*)(gbase) + (voff)[_i]), (PG8_LAS unsigned*)(lds + (bufoff) + ldsw + _i * 8192), 16, 0, 0); } while (0)
#define PG8_LDA(dst, b, h) do { _Pragma("unroll") for (int m = 0; m < 4; ++m) _Pragma("unroll") for (int k = 0; k < 2; ++k) dst[m][k] = *(const PG8_LAS bf16x8*)(lds + PG8_SA(b, h) + aoff + m * 2048 + k * 1024); } while (0)
#define PG8_LDB(dst, b, h) do { _Pragma("unroll") for (int n = 0; n < 2; ++n) _Pragma("unroll") for (int k = 0; k < 2; ++k) dst[n][k] = *(const PG8_LAS bf16x8*)(lds + PG8_SB(b, h) + boff + n * 2048 + k * 1024); } while (0)
#define PG8_MMA(ai, bj, At, Bt) do { __builtin_amdgcn_s_setprio(1); _Pragma("unroll") for (int m = 0; m < 4; ++m) _Pragma("unroll") for (int n = 0; n < 2; ++n) _Pragma("unroll") for (int k = 0; k < 2; ++k) \
        acc[ai][bj][m][n] = __builtin_amdgcn_mfma_f32_16x16x32_bf16(Bt[n][k], At[m][k], acc[ai][bj][m][n], 0, 0, 0); __builtin_amdgcn_s_setprio(0); } while (0)
#define PG8_WAIT_V(n) asm volatile("s_waitcnt vmcnt(" #n ")" ::: "memory")
#define PG8_WAIT_L(n) asm volatile("s_waitcnt lgkmcnt(" #n ")" ::: "memory")
#define PG8_BAR __builtin_amdgcn_s_barrier()
#define PG8_SCHED __builtin_amdgcn_sched_barrier(0)
    Unit cur, nxt; int ui = 0;
    if (!S.next(0, cur)) return;
    f32x4 acc[2][2][4][2];
#pragma unroll
    for (int a = 0; a < 2; ++a)
#pragma unroll
        for (int b = 0; b < 2; ++b)
#pragma unroll
            for (int m = 0; m < 4; ++m)
#pragma unroll
                for (int n = 0; n < 2; ++n) acc[a][b][m][n] = (f32x4){0.f, 0.f, 0.f, 0.f};
    bf16x8 At[4][2], B0[2][2], B1[2][2];
    const char* cA = (const char*)g.A + (size_t)cur.pm * tstep; const char* cB = (const char*)g.Bt + (size_t)cur.pn * tstep;
    S.a_ready(cur);
    if constexpr (SP2) {
        PG8_STAGE(PG8_SB(0, 0), cB, voffB); PG8_STAGE(PG8_SB(0, 1), cB + hstep, voffB); PG8_STAGE(PG8_SA(0, 0), cA, voffA); PG8_STAGE(PG8_SA(0, 1), cA + hstep, voffA);
        if (wr == 1) PG8_BAR;
        PG8_WAIT_V(2); PG8_BAR;
        PG8_STAGE(PG8_SB(1, 0), cB + kstep, voffB); PG8_STAGE(PG8_SA(1, 0), cA + kstep, voffA); PG8_STAGE(PG8_SB(1, 1), cB + hstep + kstep, voffB);
        PG8_WAIT_V(6); PG8_BAR;
    } else {
        PG8_STAGE(PG8_SB(0, 0), cB, voffB); PG8_STAGE(PG8_SA(0, 0), cA, voffA); PG8_STAGE(PG8_SB(0, 1), cB + hstep, voffB); PG8_STAGE(PG8_SA(0, 1), cA + hstep, voffA);
        if (wr == 1) PG8_BAR;
        PG8_WAIT_V(4); PG8_BAR;
        PG8_STAGE(PG8_SB(1, 0), cB + kstep, voffB); PG8_STAGE(PG8_SA(1, 0), cA + kstep, voffA); PG8_STAGE(PG8_SB(1, 1), cB + hstep + kstep, voffB);
        PG8_WAIT_V(6); PG8_BAR;
    }
    for (;;) {
        const bool has_next = S.next(ui + 1, nxt);
        const char* nA = has_next ? (const char*)g.A + (size_t)nxt.pm * tstep : cA; const char* nB = has_next ? (const char*)g.Bt + (size_t)nxt.pn * tstep : cB;
        for (int t = 0; t < nt; t += 2) {
            const bool last = (t == nt - 2);
            const char* a1 = cA + (size_t)(t + 1) * kstep;
            const char* a2 = last ? nA : cA + (size_t)(t + 2) * kstep; const char* b2 = last ? nB : cB + (size_t)(t + 2) * kstep;
            const char* a3 = a2 + kstep; const char* b3 = b2 + kstep;
            if (last && has_next) S.a_ready(nxt);
            if constexpr (SP2) {
            PG8_LDB(B0, 0, 0); PG8_LDB(B1, 0, 1); PG8_SCHED; PG8_LDA(At, 0, 0); PG8_STAGE(PG8_SA(1, 1), a1 + hstep, voffA);
            PG8_WAIT_V(8); PG8_WAIT_L(0); PG8_BAR; PG8_MMA(0, 0, At, B0); PG8_MMA(0, 1, At, B1); PG8_BAR; PG8_SCHED;
            PG8_LDA(At, 0, 1); PG8_STAGE(PG8_SB(0, 0), b2, voffB); PG8_STAGE(PG8_SB(0, 1), b2 + hstep, voffB); PG8_STAGE(PG8_SA(0, 0), a2, voffA);
            PG8_WAIT_V(8); PG8_WAIT_L(0); PG8_BAR; PG8_MMA(1, 0, At, B0); PG8_MMA(1, 1, At, B1); PG8_BAR; PG8_SCHED;
            PG8_LDB(B0, 1, 0); PG8_LDB(B1, 1, 1); PG8_SCHED; PG8_LDA(At, 1, 0); PG8_STAGE(PG8_SA(0, 1), a2 + hstep, voffA);
            PG8_WAIT_V(8); PG8_WAIT_L(0); PG8_BAR; PG8_MMA(0, 0, At, B0); PG8_MMA(0, 1, At, B1); PG8_BAR; PG8_SCHED;
            PG8_LDA(At, 1, 1); PG8_STAGE(PG8_SB(1, 0), b3, voffB); PG8_STAGE(PG8_SB(1, 1), b3 + hstep, voffB); PG8_STAGE(PG8_SA(1, 0), a3, voffA);
            PG8_WAIT_V(8); PG8_WAIT_L(0); PG8_BAR; PG8_MMA(1, 0, At, B0); PG8_MMA(1, 1, At, B1); PG8_BAR; PG8_SCHED;
            } else {
            PG8_LDB(B0, 0, 0); PG8_SCHED; PG8_LDA(At, 0, 0); PG8_STAGE(PG8_SA(1, 1), a1 + hstep, voffA);
            PG8_WAIT_L(8); PG8_BAR; PG8_WAIT_L(0); PG8_MMA(0, 0, At, B0); PG8_BAR; PG8_SCHED;
            PG8_LDB(B1, 0, 1); PG8_STAGE(PG8_SB(0, 0), b2, voffB);
            PG8_BAR; PG8_WAIT_L(0); PG8_MMA(0, 1, At, B1); PG8_BAR;
            PG8_LDA(At, 0, 1); PG8_STAGE(PG8_SA(0, 0), a2, voffA);
            PG8_BAR; PG8_WAIT_L(0); PG8_MMA(1, 0, At, B0); PG8_BAR; PG8_SCHED;
            PG8_STAGE(PG8_SB(0, 1), b2 + hstep, voffB);
            PG8_WAIT_V(6); PG8_BAR; PG8_MMA(1, 1, At, B1); PG8_BAR;
            PG8_LDB(B0, 1, 0); PG8_SCHED; PG8_LDA(At, 1, 0); PG8_STAGE(PG8_SA(0, 1), a2 + hstep, voffA);
            PG8_WAIT_L(8); PG8_BAR; PG8_WAIT_L(0); PG8_MMA(0, 0, At, B0); PG8_BAR; PG8_SCHED;
            PG8_LDB(B1, 1, 1); PG8_STAGE(PG8_SB(1, 0), b3, voffB);
            PG8_BAR; PG8_WAIT_L(0); PG8_MMA(0, 1, At, B1); PG8_BAR;
            PG8_LDA(At, 1, 1); PG8_STAGE(PG8_SA(1, 0), a3, voffA);
            PG8_BAR; PG8_WAIT_L(0); PG8_MMA(1, 0, At, B0); PG8_BAR; PG8_SCHED;
            PG8_STAGE(PG8_SB(1, 1), b3 + hstep, voffB);
            PG8_WAIT_V(6); PG8_BAR; PG8_MMA(1, 1, At, B1); PG8_BAR;
            }
        }
        if constexpr (ALIGN_EPI) { if (wr == 0) PG8_BAR; }
        if constexpr (!Epi::AFTER_DRAIN) { E(acc, cur, wr, wc, fr, fq); S.done(cur); }
        if (!has_next) break;
#pragma unroll
        for (int a = 0; a < 2; ++a)
#pragma unroll
            for (int b = 0; b < 2; ++b)
#pragma unroll
                for (int m = 0; m < 4; ++m)
#pragma unroll
                    for (int n = 0; n < 2; ++n) acc[a][b][m][n] = (f32x4){0.f, 0.f, 0.f, 0.f};
        cur = nxt; cA = nA; cB = nB; ++ui;
        if constexpr (ALIGN_EPI) { if (wr == 1) PG8_BAR; }
    }
    PG8_WAIT_V(0);
    if constexpr (!ALIGN_EPI) { if (wr == 0) PG8_BAR; }
    PG8_BAR;
    if constexpr (Epi::AFTER_DRAIN) { E.fused(acc, cur, wr, wc, fr, fq, lds, wid, lane); S.done(cur); }
#undef PG8_SA
#undef PG8_SB
#undef PG8_STAGE
#undef PG8_LDA
#undef PG8_LDB
#undef PG8_MMA
#undef PG8_WAIT_V
#undef PG8_WAIT_L
#undef PG8_BAR
#undef PG8_SCHED
}
}
#define GAS __attribute__((address_space(1)))
#define LAS __attribute__((address_space(3)))
typedef unsigned short bf16;
typedef unsigned v4u __attribute__((ext_vector_type(4)));
typedef float f32x4 __attribute__((ext_vector_type(4)));
typedef short bf16x8 __attribute__((ext_vector_type(8)));
typedef GAS unsigned gu32;
typedef GAS unsigned long long gu64;
#define RLX_AGENT __ATOMIC_RELAXED, __HIP_MEMORY_SCOPE_AGENT
#define LDS_WAIT() asm volatile("s_waitcnt lgkmcnt(0)" ::: "memory")
#define VM_WAIT() asm volatile("s_waitcnt vmcnt(0)" ::: "memory")
__device__ __forceinline__ unsigned long long rt() { return __builtin_amdgcn_s_memrealtime(); }
__device__ __forceinline__ unsigned f2bf(float f) { unsigned u = __builtin_bit_cast(unsigned, f); return (u + 0x7fffu + ((u >> 16) & 1u)) >> 16; }
__device__ __forceinline__ unsigned pk2(float lo, float hi) { return f2bf(lo) | (f2bf(hi) << 16); }

#define XB_TMO      128
#define XB_XCNT(j)  (256  + 64 * (j))
#define XB_XSUB(j)  (1280 + 64 * (j))
#define XB_XGEN(j)  (2304 + 64 * (j))
#define XB_TOP      3328
#define XB_TOPGEN   3392
#define XCD_BAR_WORDS 3456
#define XB_SPIN_CAP (1u << 18)

__device__ __forceinline__ unsigned xb_ld(unsigned* p)              { return __hip_atomic_load(p, __ATOMIC_RELAXED, __HIP_MEMORY_SCOPE_AGENT); }
__device__ __forceinline__ unsigned xb_add(unsigned* p, unsigned v) { return __hip_atomic_fetch_add(p, v, __ATOMIC_RELAXED, __HIP_MEMORY_SCOPE_AGENT); }
__device__ __forceinline__ unsigned xb_xcc_id() { return (unsigned)__builtin_amdgcn_s_getreg((3 << 11) | 20) & 0xFu; }
#define XB_SPIN(cond, bar) do { unsigned _sp = 0; while (cond) { __builtin_amdgcn_s_sleep(1); \
    if ((++_sp & 255u) == 0u) { if (xb_ld(&(bar)[XB_TMO])) break; if (_sp > XB_SPIN_CAP) { atomicAdd(&(bar)[XB_TMO], 1u); break; } } } } while (0)

struct XcdBarrier {
    unsigned* bar; unsigned x;
    volatile LAS unsigned* st;
};

__device__ __forceinline__ XcdBarrier xcd_barrier_post(unsigned* bar, volatile LAS unsigned* st) {
    XcdBarrier b; b.bar = bar; b.x = xb_xcc_id(); b.st = st;
    if (threadIdx.x == 0) (void)xb_add(&bar[XB_XCNT(b.x)], 1u);
    return b;
}
__device__ __forceinline__ void xcd_barrier_complete(unsigned* bar, unsigned x, unsigned& nloc, unsigned& nx) {
    const unsigned G = gridDim.x * gridDim.y * gridDim.z;
    unsigned sum, cnt, mine, sp = 0u;
    for (;;) {
        sum = 0u; cnt = 0u; mine = 0u;
#pragma unroll
        for (unsigned j = 0; j < 16; ++j) { const unsigned c = xb_ld(&bar[XB_XCNT(j)]); sum += c; cnt += (c > 0u) ? 1u : 0u; mine = (j == x) ? c : mine; }
        if (sum == G) break;
        __builtin_amdgcn_s_sleep(1);
        if ((++sp & 255u) == 0u) { if (xb_ld(&bar[XB_TMO])) break; if (sp > XB_SPIN_CAP) { atomicAdd(&bar[XB_TMO], 1u); break; } }
    }
    nloc = mine > 0u ? mine : 1u; nx = cnt > 0u ? cnt : 1u;
}

__device__ __forceinline__ void xcd_barrier(const XcdBarrier& b) {
    asm volatile("s_waitcnt vmcnt(0)" ::: "memory");
    __syncthreads();
    if (threadIdx.x == 0) {
        unsigned* bar = b.bar;
        __builtin_amdgcn_s_waitcnt(0);
        unsigned nloc = b.st[0], nx = b.st[1];
        if (nloc == 0u) { xcd_barrier_complete(bar, b.x, nloc, nx); b.st[0] = nloc; b.st[1] = nx; }
        const unsigned old = xb_add(&bar[XB_XSUB(b.x)], 1u);
        const unsigned gen = old / nloc;
        if (old + 1u == (gen + 1u) * nloc) {
            __builtin_amdgcn_fence(__ATOMIC_RELEASE, "agent");
            asm volatile("s_waitcnt vmcnt(0)" ::: "memory");
            const unsigned og = xb_add(&bar[XB_TOP], 1u);
            const unsigned tg = og / nx;
            if (og + 1u == (tg + 1u) * nx) xb_add(&bar[XB_TOPGEN], 1u);
            else XB_SPIN(xb_ld(&bar[XB_TOPGEN]) == tg, bar);
            __builtin_amdgcn_fence(__ATOMIC_ACQUIRE, "agent");
            xb_add(&bar[XB_XGEN(b.x)], 1u);
            asm volatile("s_waitcnt vmcnt(0)" ::: "memory");
        } else {
            XB_SPIN(xb_ld(&bar[XB_XGEN(b.x)]) == gen, bar);
            __builtin_amdgcn_fence(__ATOMIC_ACQUIRE, "agent");
            asm volatile("s_waitcnt vmcnt(0)" ::: "memory");
        }
    }
    __syncthreads();
}

constexpr int NWAVES = 8;
#ifndef MK_N_LAUNCHES
#define MK_N_LAUNCHES 1
#endif
constexpr int NPHASE = 8;
constexpr int N_LAUNCHES = MK_N_LAUNCHES;

constexpr int BATCH = 2, SEQ = 8192, DM = 2048, M = BATCH * SEQ, NH = 16, HD = 64;
constexpr int N1 = 8704, IN_W = 8480, NLORA = 3072, KLORA = 384;
constexpr float NORM_EPS = 1e-5f, LNX_EPS = 64e-5f;
constexpr float C2Q = 0.125f * 1.4426950408889634f;

constexpr size_t MiB = 1u << 20;
constexpr size_t WS_CTL = 0, CTL_ZERO_BYTES = 1 * MiB;
constexpr size_t WS_SSQ = 1 * MiB;
constexpr size_t WS_COS = 2 * MiB, WS_SIN = 3 * MiB;
constexpr size_t WS_BTL = 4 * MiB;
constexpr size_t WS_BT2 = 8 * MiB;
constexpr size_t WS_BT1 = 16 * MiB;
constexpr size_t WS_XN = 50 * MiB;
constexpr size_t WS_OP = 16 * MiB;
constexpr size_t WS_XL = 16 * MiB;
constexpr size_t WS_SA = 114 * MiB;
constexpr size_t WS_SB = 242 * MiB;
constexpr size_t WS_SC = 338 * MiB;
constexpr size_t WS_SD = 370 * MiB;
constexpr size_t WS_MIX = 386 * MiB;
constexpr size_t WS_AL = 450 * MiB;
constexpr size_t WS_LSE = 462 * MiB;
constexpr size_t WS_END = 512 * MiB;
constexpr int CW_BAR = 4096;

constexpr int RING_BYTES = 131072, LDSCTL_OFF = RING_BYTES, MISC_OFF = LDSCTL_OFF + 320, LDS_BYTES = 147456;

typedef float f32x16 __attribute__((ext_vector_type(16)));
typedef short s16x4 __attribute__((ext_vector_type(4)));
typedef unsigned u32x2 __attribute__((ext_vector_type(2)));

__device__ __forceinline__ float wave_sum(float v) {
#pragma unroll
    for (int o = 1; o < 64; o <<= 1) v += __shfl_xor(v, o);
    return v;
}
__device__ __forceinline__ float bf2f(unsigned short b) { return __builtin_bit_cast(float, (unsigned)b << 16); }
__device__ __forceinline__ float bflo(unsigned w) { return __builtin_bit_cast(float, w << 16); }
__device__ __forceinline__ float bfhi(unsigned w) { return __builtin_bit_cast(float, w & 0xffff0000u); }
__device__ __forceinline__ float sigmoidf_(float x) { return __builtin_amdgcn_rcpf(1.0f + __expf(-x)); }
__device__ __forceinline__ float siluf_(float x) { return x * sigmoidf_(x); }
__device__ __forceinline__ void unpack8(const v4u w, float (&f)[8]) {
    f[0] = bflo(w.x); f[1] = bfhi(w.x); f[2] = bflo(w.y); f[3] = bfhi(w.y); f[4] = bflo(w.z); f[5] = bfhi(w.z); f[6] = bflo(w.w); f[7] = bfhi(w.w);
}
__device__ __forceinline__ v4u pack8(const float (&f)[8]) { v4u w; w.x = pk2(f[0], f[1]); w.y = pk2(f[2], f[3]); w.z = pk2(f[4], f[5]); w.w = pk2(f[6], f[7]); return w; }
__device__ __forceinline__ float red8(float x) {
    x += __builtin_bit_cast(float, __builtin_amdgcn_update_dpp(0, __builtin_bit_cast(int, x), 0x141, 0xf, 0xf, true));
    x += __builtin_bit_cast(float, __builtin_amdgcn_update_dpp(0, __builtin_bit_cast(int, x), 0xB1, 0xf, 0xf, true));
    x += __builtin_bit_cast(float, __builtin_amdgcn_update_dpp(0, __builtin_bit_cast(int, x), 0x4E, 0xf, 0xf, true));
    return x;
}

struct Frame {
    LAS unsigned char* lds;
    int tid, lane, wave, vcu, G;
    const float *x, *norm_g, *w_in, *shift_mu, *w0, *w2, *a0, *a2, *g2, *k_k, *k_a, *r_k, *lnx_g, *lnx_b, *w_out, *final_g;
    float* out; unsigned char* ws;
};

__device__ __forceinline__ int gemm1_row_of_col(int o) {
    if (o < 2048) { const int d = o & 63, base = o - d; return base + (d < 32 ? 8 * (d >> 2) + (d & 3) : 8 * ((d - 32) >> 2) + 4 + (d & 3)); }
    if (o < 7168) return o;
    if (o < 7456) return o + 1024;
    return o - 288;
}
template <bool MAP>
__device__ __forceinline__ void transpose_item(const float* W, int K, int N, bf16* WT, LAS float* scr, int item, int lane) {
    const int nblk = N / 32, kb = item / nblk, nb = item % nblk, k0 = 64 * kb, n0 = 32 * nb;
#pragma unroll 8
    for (int i = 0; i < 32; ++i) { const int kk = 2 * i + (lane >> 5); scr[kk * 33 + (lane & 31)] = W[(size_t)(k0 + kk) * N + n0 + (lane & 31)]; }
    LDS_WAIT(); asm volatile("" ::: "memory");
    const int c = lane & 7;
#pragma unroll
    for (int j = 0; j < 4; ++j) { const int n = (lane >> 3) + 8 * j; const LAS float* s = scr + (8 * c) * 33 + n;
        v4u o; o.x = pk2(s[0 * 33], s[1 * 33]); o.y = pk2(s[2 * 33], s[3 * 33]); o.z = pk2(s[4 * 33], s[5 * 33]); o.w = pk2(s[6 * 33], s[7 * 33]);
        const int row = MAP ? gemm1_row_of_col(n0 + n) : (n0 + n);
        *(GAS v4u*)(WT + (size_t)row * K + k0 + 8 * c) = o; }
    LDS_WAIT(); asm volatile("" ::: "memory");
}
__device__ __forceinline__ void rms_row_to_bf16(const float* xrow, const float* g, bf16* orow, int lane) {
    const GAS f32x4* xr = (const GAS f32x4*)xrow + lane; const GAS f32x4* gr = (const GAS f32x4*)g + lane;
    f32x4 v[8]; float s = 0.f;
#pragma unroll
    for (int j = 0; j < 8; ++j) { v[j] = xr[64 * j]; s += (v[j].x * v[j].x + v[j].y * v[j].y) + (v[j].z * v[j].z + v[j].w * v[j].w); }
    const float rs = 1.0f / sqrtf(wave_sum(s) * (1.0f / DM) + NORM_EPS);
    GAS u32x2* o8 = (GAS u32x2*)orow + lane;
#pragma unroll
    for (int j = 0; j < 8; ++j) { const f32x4 gv = gr[64 * j]; u32x2 w; w.x = pk2(v[j].x * rs * gv.x, v[j].y * rs * gv.y); w.y = pk2(v[j].z * rs * gv.z, v[j].w * rs * gv.w); o8[64 * j] = w; }
}
__device__ __forceinline__ void p0_prologue(Frame& F) {
    LAS float* scr = (LAS float*)(F.lds + F.wave * 16384);
    const int gw = F.vcu * NWAVES + F.wave, NGW = F.G * NWAVES;
    const int gt = gw * 64 + F.lane, NGT = NGW * 64;
    bf16* BT1 = (bf16*)(F.ws + WS_BT1); bf16* BT2 = (bf16*)(F.ws + WS_BT2); bf16* BTL = (bf16*)(F.ws + WS_BTL); bf16* XN = (bf16*)(F.ws + WS_XN);
    constexpr int I_1 = (DM / 64) * (IN_W / 32), I_2 = (DM / 64) * (DM / 32);
    for (int it = gw; it < I_1 + I_2; it += NGW) {
        if (it < I_1) transpose_item<true>(F.w_in, DM, IN_W, BT1, scr, it, F.lane);
        else transpose_item<false>(F.w_out, DM, DM, BT2, scr, it - I_1, F.lane);
    }
    for (int i = gt; i < (N1 - IN_W) * DM / 8; i += NGT) ((GAS v4u*)(BT1 + (size_t)IN_W * DM))[i] = (v4u){0u, 0u, 0u, 0u};
    for (int i = gt; i < KLORA * 1024; i += NGT) { const int k = i >> 10, ch = i & 1023;
        const float vw = (k < 64) ? F.w2[k * 1024 + ch] : 0.f, va = (k >= 64 && k < 128) ? F.a2[(k - 64) * 1024 + ch] : 0.f, vg = (k >= 128 && k < 288) ? F.g2[(k - 128) * 1024 + ch] : 0.f;
        BTL[(size_t)ch * KLORA + k] = (bf16)f2bf(vw); BTL[(size_t)(1024 + ch) * KLORA + k] = (bf16)f2bf(va); BTL[(size_t)(2048 + ch) * KLORA + k] = (bf16)f2bf(vg); }
    { float* ct = (float*)(F.ws + WS_COS); float* st = (float*)(F.ws + WS_SIN);
      for (int i = gt; i < SEQ * 32; i += NGT) { const int pos = i >> 5, fi = i & 31;
          const double rev = (double)pos * exp2(-(double)fi * (13.287712379549449 / 32.0)) * 0.15915494309189535;
          const float fr = (float)(rev - floor(rev));
          ct[i] = __builtin_amdgcn_cosf(fr); st[i] = __builtin_amdgcn_sinf(fr); } }
    { float* ssq = (float*)(F.ws + WS_SSQ); for (int i = gt; i < M; i += NGT) ssq[i] = 0.f; }
    for (int m = gw; m < M; m += NGW) rms_row_to_bf16(F.x + (size_t)m * DM, F.norm_g, XN + (size_t)m * DM, F.lane);
}

struct EpiProj {
    static constexpr bool PERM = true, AFTER_DRAIN = false;
    pg8::bf16_t *SA, *SB, *SC, *SD; const float* cosT; const float* sinT;
    __device__ __forceinline__ void operator()(const pg8::f32x4 (&acc)[2][2][4][2], const pg8::Unit& u, int wr, int wc, int fr, int fq) const {
        const int pn = u.pn; pg8::bf16_t* base; int ld, colt, kind;
        if (pn < 16) { base = SA; ld = 4096; colt = 256 * pn; kind = pn < 4 ? 0 : pn < 8 ? 1 : pn < 12 ? 2 : 3; }
        else if (pn < 28) { base = SB; ld = 3072; colt = 256 * (pn - 16); kind = 2; }
        else if (pn < 32) { base = SC; ld = 1024; colt = 256 * (pn - 28); kind = 3; }
        else { base = SD; ld = 512; colt = 256 * (pn - 32); kind = 2; }
        const int row0 = u.pm * 256 + wr * 64 + fr, col0 = colt + wc * 32 + 8 * fq, e4 = 4 * (4 * (wc & 1) + fq);
#pragma unroll
        for (int ai = 0; ai < 2; ++ai)
#pragma unroll
            for (int m = 0; m < 4; ++m) { const int row = row0 + ai * 128 + m * 16; pg8::bf16_t* rowp = base + (size_t)row * ld + col0;
                pg8::f32x4 cs = {1.f, 1.f, 1.f, 1.f}, sn = {0.f, 0.f, 0.f, 0.f};
                if (kind <= 1) { const int pos = row & (SEQ - 1); cs = *(const pg8::f32x4*)(cosT + pos * 32 + e4); sn = *(const pg8::f32x4*)(sinT + pos * 32 + e4); }
#pragma unroll
                for (int bj = 0; bj < 2; ++bj) { pg8::f32x4 v0 = acc[ai][bj][m][0], v1 = acc[ai][bj][m][1];
                    if (kind <= 1) { const pg8::f32x4 o0 = v0 * cs - v1 * sn, o1 = v1 * cs + v0 * sn; const float s = kind == 0 ? C2Q : 1.0f; v0 = o0 * s; v1 = o1 * s; }
                    else if (kind == 3) {
#pragma unroll
                        for (int i = 0; i < 4; ++i) { v0[i] = siluf_(v0[i]); v1[i] = siluf_(v1[i]); } }
                    pg8::u32x4 w; w.x = pg8::cvt_pk_bf16(v0[0], v0[1]); w.y = pg8::cvt_pk_bf16(v0[2], v0[3]); w.z = pg8::cvt_pk_bf16(v1[0], v1[1]); w.w = pg8::cvt_pk_bf16(v1[2], v1[3]);
                    *(pg8::u32x4*)(rowp + bj * 128) = w; } }
    }
};
struct EpiOut {
    static constexpr bool PERM = false, AFTER_DRAIN = false;
    const float* x; float* out; float* ssq;
    __device__ __forceinline__ void operator()(const pg8::f32x4 (&acc)[2][2][4][2], const pg8::Unit& u, int wr, int wc, int fr, int fq) const {
        const int row0 = u.pm * 256 + wr * 64 + fr, col0 = u.pn * 256 + wc * 32 + 4 * fq;
#pragma unroll
        for (int ai = 0; ai < 2; ++ai)
#pragma unroll
            for (int m = 0; m < 4; ++m) { const int row = row0 + ai * 128 + m * 16; const size_t off = (size_t)row * DM + col0; float s = 0.f;
#pragma unroll
                for (int bj = 0; bj < 2; ++bj)
#pragma unroll
                    for (int n = 0; n < 2; ++n) { const pg8::f32x4 y = *(const pg8::f32x4*)(x + off + bj * 128 + n * 16) + acc[ai][bj][m][n];
                        *(pg8::f32x4*)(out + off + bj * 128 + n * 16) = y; s += (y[0] * y[0] + y[1] * y[1]) + (y[2] * y[2] + y[3] * y[3]); }
                s += __shfl_xor(s, 16); s += __shfl_xor(s, 32);
                if (fq == 0) atomicAdd(ssq + row, s); }
    }
};

constexpr int ATT_VP = 192;
constexpr int ATT_WLDS = 32 * ATT_VP + 4096 + 256;
__device__ __forceinline__ int crow(int r, int hi) { return (r & 3) + 8 * (r >> 2) + 4 * hi; }
__device__ __forceinline__ s16x4 vtr(const LAS unsigned char* p) { return __builtin_bit_cast(s16x4, __builtin_amdgcn_ds_read_tr16_b64_v4i16((LAS s16x4*)p)); }

__device__ __forceinline__ void attn_item(const bf16* SA, int dil, int b, int h, int r, int m0, bf16* Op, float* Lp, LAS unsigned char* wl, int lane) {
    const int q32 = lane & 31, hi = lane >> 5;
    const size_t tokb = (size_t)b * SEQ;
    const bf16* qrow = SA + (tokb + (size_t)(m0 + q32) * dil + r) * 4096 + h * 64;
    bf16x8 qf[4];
#pragma unroll
    for (int s = 0; s < 4; ++s) qf[s] = *(const bf16x8*)(qrow + 16 * s + 8 * hi);
    const int tmin = m0 >= 128 ? 0 : (128 - m0) >> 5;
    f32x16 sc[5];
#pragma unroll
    for (int t = 0; t < 5; ++t) {
        if (t < tmin) {
#pragma unroll
            for (int i = 0; i < 16; ++i) sc[t][i] = -INFINITY;
        } else {
            const bf16* krow = SA + (tokb + (size_t)(m0 - 128 + 32 * t + q32) * dil + r) * 4096 + 1024 + h * 64;
            bf16x8 kf[4];
#pragma unroll
            for (int s = 0; s < 4; ++s) kf[s] = *(const bf16x8*)(krow + 16 * s + 8 * hi);
            f32x16 a = {};
#pragma unroll
            for (int s = 0; s < 4; ++s) a = __builtin_amdgcn_mfma_f32_32x32x16_bf16(kf[s], qf[s], a, 0, 0, 0);
            if (t == 0) {
#pragma unroll
                for (int i = 0; i < 16; ++i) if (crow(i, hi) < q32) a[i] = -INFINITY;
            }
            if (t == 4) {
#pragma unroll
                for (int i = 0; i < 16; ++i) if (crow(i, hi) > q32) a[i] = -INFINITY;
            }
            sc[t] = a;
        }
    }
    float mx = -INFINITY;
#pragma unroll
    for (int t = 0; t < 5; ++t)
#pragma unroll
        for (int i = 0; i < 16; ++i) mx = fmaxf(mx, sc[t][i]);
    mx = fmaxf(mx, __shfl_xor(mx, 32));
    float l = 0.f;
#pragma unroll
    for (int t = 0; t < 5; ++t)
#pragma unroll
        for (int i = 0; i < 16; ++i) { const float p = __builtin_amdgcn_exp2f(sc[t][i] - mx); sc[t][i] = p; l += p; }
    l += __shfl_xor(l, 32);
    LAS float* wsf = (LAS float*)(wl + 32 * ATT_VP + 4096);
    if (hi == 0) wsf[q32] = __builtin_amdgcn_rcpf(l);
    f32x16 o[2]; o[0] = f32x16{}; o[1] = f32x16{};
    const LAS unsigned char* vrd = wl + (4 * hi + ((lane & 15) >> 2)) * ATT_VP + ((lane >> 4) & 1) * 32 + (lane & 3) * 8;
#pragma unroll
    for (int t = 0; t < 5; ++t) {
        if (t >= tmin) {
#pragma unroll
            for (int i = 0; i < 4; ++i) { const int row = (lane >> 3) + 8 * i, ch = lane & 7;
                const v4u v = *(const GAS v4u*)(SA + (tokb + (size_t)(m0 - 128 + 32 * t + row) * dil + r) * 4096 + 2048 + h * 64 + ch * 8);
                *(LAS v4u*)(wl + row * ATT_VP + ch * 16) = v; }
            LDS_WAIT(); asm volatile("" ::: "memory");
#pragma unroll
            for (int s2 = 0; s2 < 2; ++s2) {
                v4u pw; pw.x = pk2(sc[t][8 * s2 + 0], sc[t][8 * s2 + 1]); pw.y = pk2(sc[t][8 * s2 + 2], sc[t][8 * s2 + 3]); pw.z = pk2(sc[t][8 * s2 + 4], sc[t][8 * s2 + 5]); pw.w = pk2(sc[t][8 * s2 + 6], sc[t][8 * s2 + 7]);
                const bf16x8 pa = __builtin_bit_cast(bf16x8, pw);
#pragma unroll
                for (int db = 0; db < 2; ++db) {
                    const s16x4 lo = vtr(vrd + (16 * s2) * ATT_VP + db * 64), hh = vtr(vrd + (16 * s2 + 8) * ATT_VP + db * 64);
                    const bf16x8 vb = {lo[0], lo[1], lo[2], lo[3], hh[0], hh[1], hh[2], hh[3]};
                    o[db] = __builtin_amdgcn_mfma_f32_32x32x16_bf16(pa, vb, o[db], 0, 0, 0);
                }
            }
            LDS_WAIT(); asm volatile("" ::: "memory");
        }
    }
    LAS bf16* stg = (LAS bf16*)(wl + 32 * ATT_VP);
#pragma unroll
    for (int i = 0; i < 16; ++i) { const int q = crow(i, hi); const float li = wsf[q];
        stg[q * 64 + q32] = (bf16)f2bf(o[0][i] * li); stg[q * 64 + 32 + q32] = (bf16)f2bf(o[1][i] * li); }
    LDS_WAIT(); asm volatile("" ::: "memory");
#pragma unroll
    for (int i = 0; i < 4; ++i) { const int row = i * 8 + (lane >> 3), ch = lane & 7; const v4u v = *(const LAS v4u*)(stg + row * 64 + ch * 8);
        *(GAS v4u*)(Op + (tokb + (size_t)(m0 + row) * dil + r) * 1024 + h * 64 + ch * 8) = v; }
    if (hi == 0) Lp[(tokb + (size_t)(m0 + q32) * dil + r) * 16 + h] = mx + __builtin_amdgcn_logf(l);
    LDS_WAIT(); asm volatile("" ::: "memory");
}
__device__ __forceinline__ void attn_phase(Frame& F) {
    const bf16* SA = (const bf16*)(F.ws + WS_SA);
    LAS unsigned char* wl = F.lds + F.wave * ATT_WLDS;
    const int gw = F.vcu * NWAVES + F.wave, NGW = F.G * NWAVES;
    for (int it = gw; it < 3 * 8192; it += NGW) {
        const int pat = it >> 13, rem = it & 8191, bh = rem >> 8, tile = rem & 255;
        const int dil = pat == 0 ? 1 : pat == 1 ? 4 : 16, tpc = 256 / dil;
        const int r = tile / tpc, m0 = 32 * (tile % tpc);
        attn_item(SA, dil, bh >> 4, bh & 15, r, m0, (bf16*)(F.ws + WS_OP) + (size_t)pat * M * 1024, (float*)(F.ws + WS_LSE) + (size_t)pat * M * 16, wl, F.lane);
    }
}
__device__ __forceinline__ void lora_act_phase(Frame& F) {
    const bf16* SD = (const bf16*)(F.ws + WS_SD); bf16* AL = (bf16*)(F.ws + WS_AL);
    const int gt = (F.vcu * NWAVES + F.wave) * 64 + F.lane, NGT = F.G * NWAVES * 64;
    for (int i = gt; i < M * (KLORA / 8); i += NGT) { const int m = i / (KLORA / 8), c8 = (i % (KLORA / 8)) * 8;
        v4u o = {0u, 0u, 0u, 0u};
        if (c8 < 288) {
            float cur[8], prv[8], f[8];
            unpack8(*(const GAS v4u*)(SD + (size_t)m * 512 + c8), cur);
            if ((m & (SEQ - 1)) != 0) unpack8(*(const GAS v4u*)(SD + (size_t)(m - 1) * 512 + c8), prv);
            else {
#pragma unroll
                for (int e = 0; e < 8; ++e) prv[e] = 0.f; }
#pragma unroll
            for (int e = 0; e < 8; ++e) { const float mu = F.shift_mu[3072 + c8 + e]; const float xs = cur[e] + (prv[e] - cur[e]) * mu;
                f[e] = c8 < 64 ? tanhf(xs) : c8 < 128 ? xs : sigmoidf_(xs); }
            o = pack8(f);
        }
        *(GAS v4u*)(AL + (size_t)m * KLORA + c8) = o; }
}
__device__ __forceinline__ void combine_phase(Frame& F) {
    const bf16* SA = (const bf16*)(F.ws + WS_SA); const bf16* OP = (const bf16*)(F.ws + WS_OP); const float* LS = (const float*)(F.ws + WS_LSE); bf16* MIX = (bf16*)(F.ws + WS_MIX);
    const int gt = (F.vcu * NWAVES + F.wave) * 64 + F.lane, NGT = F.G * NWAVES * 64;
    for (int i = gt; i < M * 128; i += NGT) { const int m = i >> 7, c8 = (i & 127) * 8, h = c8 >> 6;
        const float l0 = LS[(size_t)m * 16 + h], l1 = LS[(size_t)(M + m) * 16 + h], l2 = LS[(size_t)(2 * M + m) * 16 + h];
        const float mx = fmaxf(l0, fmaxf(l1, l2));
        float w0 = __builtin_amdgcn_exp2f(l0 - mx), w1 = __builtin_amdgcn_exp2f(l1 - mx), w2 = __builtin_amdgcn_exp2f(l2 - mx);
        const float inv = 1.0f / (w0 + w1 + w2); w0 *= inv; w1 *= inv; w2 *= inv;
        float a[8], bq[8], c[8], z[8], f[8];
        unpack8(*(const GAS v4u*)(OP + (size_t)m * 1024 + c8), a); unpack8(*(const GAS v4u*)(OP + (size_t)(M + m) * 1024 + c8), bq); unpack8(*(const GAS v4u*)(OP + (size_t)(2 * M + m) * 1024 + c8), c);
        unpack8(*(const GAS v4u*)(SA + (size_t)m * 4096 + 3072 + c8), z);
#pragma unroll
        for (int e = 0; e < 8; ++e) f[e] = (w0 * a[e] + w1 * bq[e] + w2 * c[e]) * z[e];
        *(GAS v4u*)(MIX + (size_t)m * 2048 + c8) = pack8(f); }
}
__device__ __forceinline__ void rwkv_seq_phase(Frame& F) {
    if (F.vcu >= BATCH * NH) return;
    const int b = F.vcu >> 4, h = F.vcu & 15, tid = F.tid;
    const bf16* SB = (const bf16*)(F.ws + WS_SB); const bf16* SC = (const bf16*)(F.ws + WS_SC); const bf16* XL = (const bf16*)(F.ws + WS_XL); bf16* MIX = (bf16*)(F.ws + WS_MIX);
    LAS float* LR = (LAS float*)F.lds; LAS float* LW = LR + 4096; LAS float* LK = LW + 4096; LAS float* LA = LK + 4096; LAS float* LB = LA + 4096; LAS float* LV = LB + 4096; LAS float* LY = LV + 4096;
    const int tok = tid >> 3, cg = tid & 7, ch0 = h * 64 + 8 * cg;
    float mu_r[8], mu_k[8], mu_v[8], w0v[8], a0v[8], kkv[8], kav[8], rkv[8], lg[8], lb[8];
#pragma unroll
    for (int e = 0; e < 8; ++e) { mu_r[e] = F.shift_mu[ch0 + e]; mu_k[e] = F.shift_mu[1024 + ch0 + e]; mu_v[e] = F.shift_mu[2048 + ch0 + e]; w0v[e] = F.w0[ch0 + e]; a0v[e] = F.a0[ch0 + e];
        kkv[e] = F.k_k[ch0 + e]; kav[e] = F.k_a[ch0 + e]; rkv[e] = F.r_k[ch0 + e]; lg[e] = F.lnx_g[ch0 + e]; lb[e] = F.lnx_b[ch0 + e]; }
    float st[8];
#pragma unroll
    for (int e = 0; e < 8; ++e) st[e] = 0.f;
    for (int c = 0; c < SEQ / 64; ++c) {
        const size_t m = (size_t)b * SEQ + c * 64 + tok;
        {
            float r[8], k[8], v[8], pr[8], pk[8], pv[8], xw[8], xa[8];
            unpack8(*(const GAS v4u*)(SB + m * 3072 + ch0), r); unpack8(*(const GAS v4u*)(SB + m * 3072 + 1024 + ch0), k); unpack8(*(const GAS v4u*)(SB + m * 3072 + 2048 + ch0), v);
            if (c * 64 + tok != 0) { unpack8(*(const GAS v4u*)(SB + (m - 1) * 3072 + ch0), pr); unpack8(*(const GAS v4u*)(SB + (m - 1) * 3072 + 1024 + ch0), pk); unpack8(*(const GAS v4u*)(SB + (m - 1) * 3072 + 2048 + ch0), pv); }
            else {
#pragma unroll
                for (int e = 0; e < 8; ++e) { pr[e] = 0.f; pk[e] = 0.f; pv[e] = 0.f; } }
            unpack8(*(const GAS v4u*)(XL + m * 3072 + ch0), xw); unpack8(*(const GAS v4u*)(XL + m * 3072 + 1024 + ch0), xa);
            float kk[8], ss = 0.f, as[8];
#pragma unroll
            for (int e = 0; e < 8; ++e) { r[e] += (pr[e] - r[e]) * mu_r[e]; k[e] += (pk[e] - k[e]) * mu_k[e]; v[e] += (pv[e] - v[e]) * mu_v[e];
                as[e] = sigmoidf_(a0v[e] + xa[e]); kk[e] = k[e] * kkv[e]; ss += kk[e] * kk[e]; }
            ss = red8(ss); const float inv = 1.0f / fmaxf(sqrtf(ss), 1e-12f);
#pragma unroll
            for (int e = 0; e < 8; ++e) { const float kn = kk[e] * inv; const int o = tok * 64 + 8 * cg + e;
                LR[o] = r[e]; LW[o] = __expf(-0.6065306597126334f * sigmoidf_(w0v[e] + xw[e])); LK[o] = k[e] * (1.0f + (as[e] - 1.0f) * kav[e]); LA[o] = -kn; LB[o] = kn * as[e]; LV[o] = v[e]; }
        }
        __syncthreads();
        {
            const int i = tid >> 3, jo = 8 * (tid & 7);
            for (int t = 0; t < 64; ++t) {
                const f32x4 a0 = *(const LAS f32x4*)(LA + t * 64 + jo), a1 = *(const LAS f32x4*)(LA + t * 64 + jo + 4);
                float sa = (st[0] * a0[0] + st[1] * a0[1]) + (st[2] * a0[2] + st[3] * a0[3]) + (st[4] * a1[0] + st[5] * a1[1]) + (st[6] * a1[2] + st[7] * a1[3]);
                sa = red8(sa);
                const f32x4 w0_ = *(const LAS f32x4*)(LW + t * 64 + jo), w1_ = *(const LAS f32x4*)(LW + t * 64 + jo + 4);
                const f32x4 b0 = *(const LAS f32x4*)(LB + t * 64 + jo), b1 = *(const LAS f32x4*)(LB + t * 64 + jo + 4);
                const f32x4 k0 = *(const LAS f32x4*)(LK + t * 64 + jo), k1 = *(const LAS f32x4*)(LK + t * 64 + jo + 4);
                const f32x4 r0 = *(const LAS f32x4*)(LR + t * 64 + jo), r1 = *(const LAS f32x4*)(LR + t * 64 + jo + 4);
                const float vi = LV[t * 64 + i];
#pragma unroll
                for (int e = 0; e < 4; ++e) { st[e] = st[e] * w0_[e] + sa * b0[e] + vi * k0[e]; st[4 + e] = st[4 + e] * w1_[e] + sa * b1[e] + vi * k1[e]; }
                float y = (st[0] * r0[0] + st[1] * r0[1]) + (st[2] * r0[2] + st[3] * r0[3]) + (st[4] * r1[0] + st[5] * r1[1]) + (st[6] * r1[2] + st[7] * r1[3]);
                y = red8(y);
                if ((tid & 7) == 0) LY[t * 64 + i] = y;
            }
        }
        __syncthreads();
        {
            float y[8], s = 0.f, q = 0.f, bon = 0.f, g[8], z[8], f[8];
#pragma unroll
            for (int e = 0; e < 8; ++e) { y[e] = LY[tok * 64 + 8 * cg + e]; s += y[e]; }
            const float mean = red8(s) * (1.0f / 64.0f);
#pragma unroll
            for (int e = 0; e < 8; ++e) { y[e] -= mean; q += y[e] * y[e]; bon += LR[tok * 64 + 8 * cg + e] * LK[tok * 64 + 8 * cg + e] * rkv[e]; }
            const float rstd = 1.0f / sqrtf(red8(q) * (1.0f / 64.0f) + LNX_EPS); bon = red8(bon);
            unpack8(*(const GAS v4u*)(XL + m * 3072 + 2048 + ch0), g); unpack8(*(const GAS v4u*)(SC + m * 1024 + ch0), z);
#pragma unroll
            for (int e = 0; e < 8; ++e) f[e] = (y[e] * rstd * lg[e] + lb[e] + bon * LV[tok * 64 + 8 * cg + e]) * g[e] * z[e];
            *(GAS v4u*)(MIX + m * 2048 + 1024 + ch0) = pack8(f);
        }
        __syncthreads();
    }
}
__device__ __forceinline__ void final_norm_phase(Frame& F) {
    const float* ssq = (const float*)(F.ws + WS_SSQ);
    const int gw = F.vcu * NWAVES + F.wave, NGW = F.G * NWAVES;
    for (int m = gw; m < M; m += NGW) {
        const float rs = 1.0f / sqrtf(ssq[m] * (1.0f / DM) + NORM_EPS);
        GAS f32x4* yr = (GAS f32x4*)(F.out + (size_t)m * DM) + F.lane; const GAS f32x4* gr = (const GAS f32x4*)F.final_g + F.lane;
#pragma unroll
        for (int j = 0; j < 8; ++j) { const f32x4 v = yr[64 * j], g = gr[64 * j]; yr[64 * j] = v * rs * g; }
    }
}

struct Args { const float* in[16]; float* out; unsigned char* ws; int ph_lo, ph_hi, li, pad; };
__global__ void __launch_bounds__(NWAVES * 64, 2) hymba_fwd(Args args) {
    extern __shared__ __attribute__((aligned(16))) unsigned char lds[];
    Frame F;
    F.lds = (LAS unsigned char*)lds;
    F.tid = threadIdx.x; F.lane = F.tid & 63; F.wave = __builtin_amdgcn_readfirstlane(F.tid >> 6);
    F.G = gridDim.x; { const int bx = blockIdx.x; F.vcu = (F.G % 8 == 0) ? (bx % 8) * (F.G / 8) + bx / 8 : bx; }
    F.x = args.in[0]; F.norm_g = args.in[1]; F.w_in = args.in[2]; F.shift_mu = args.in[3]; F.w0 = args.in[4]; F.w2 = args.in[5]; F.a0 = args.in[6]; F.a2 = args.in[7]; F.g2 = args.in[8];
    F.k_k = args.in[9]; F.k_a = args.in[10]; F.r_k = args.in[11]; F.lnx_g = args.in[12]; F.lnx_b = args.in[13]; F.w_out = args.in[14]; F.final_g = args.in[15];
    F.out = args.out; F.ws = args.ws;
    volatile LAS unsigned* MISC = (volatile LAS unsigned*)(F.lds + MISC_OFF);
    for (int u = F.tid; u < (LDS_BYTES - LDSCTL_OFF) / 4; u += NWAVES * 64) ((LAS unsigned*)(F.lds + LDSCTL_OFF))[u] = 0u;
    __syncthreads();
    gu32* ctl = (gu32*)(F.ws + WS_CTL);
    XcdBarrier bar; bar.bar = (unsigned*)(ctl + CW_BAR); bar.x = 0; bar.st = nullptr;
    if (N_LAUNCHES != NPHASE) bar = xcd_barrier_post((unsigned*)(ctl + CW_BAR) + args.li * XCD_BAR_WORDS, MISC + 8);
    const int lo = args.ph_lo, hi = args.ph_hi;
#ifndef PHMASK
#define PHMASK 0xff
#endif
#define IN(k) (((PHMASK >> (k)) & 1) && lo <= (k) && (k) < hi)
#define SEAM(k) do { if (IN(k) && IN((k) + 1)) xcd_barrier(bar); } while (0)
    if (IN(0)) { p0_prologue(F); } SEAM(0);
    if (IN(1)) {
        pg8::Gemm g{(const pg8::bf16_t*)(F.ws + WS_XN), (const pg8::bf16_t*)(F.ws + WS_BT1), M, N1, DM + args.pad}; pg8::StaticOrder S; S.init(M, N1, F.G, (int)blockIdx.x);
        EpiProj E{(pg8::bf16_t*)(F.ws + WS_SA), (pg8::bf16_t*)(F.ws + WS_SB), (pg8::bf16_t*)(F.ws + WS_SC), (pg8::bf16_t*)(F.ws + WS_SD), (const float*)(F.ws + WS_COS), (const float*)(F.ws + WS_SIN)};
        pg8::gemm_phase<EpiProj, pg8::StaticOrder, true, true>(F.lds, g, S, E);
    } SEAM(1);
    if (IN(2)) { attn_phase(F); lora_act_phase(F); } SEAM(2);
    if (IN(3)) { combine_phase(F); } SEAM(3);
    if (IN(4)) {
        pg8::Gemm g{(const pg8::bf16_t*)(F.ws + WS_AL), (const pg8::bf16_t*)(F.ws + WS_BTL), M, NLORA, KLORA + args.pad}; pg8::StaticOrder S; S.init(M, NLORA, F.G, (int)blockIdx.x);
        pg8::EpiBf16<0> E{(pg8::bf16_t*)(F.ws + WS_XL), NLORA, nullptr, 0, 0, 1.f};
        pg8::gemm_phase<pg8::EpiBf16<0>, pg8::StaticOrder, true, true>(F.lds, g, S, E);
    } SEAM(4);
    if (IN(5)) { rwkv_seq_phase(F); } SEAM(5);
    if (IN(6)) {
        pg8::Gemm g{(const pg8::bf16_t*)(F.ws + WS_MIX), (const pg8::bf16_t*)(F.ws + WS_BT2), M, DM, DM + args.pad}; pg8::StaticOrder S; S.init(M, DM, F.G, (int)blockIdx.x);
        EpiOut E{F.x, F.out, (float*)(F.ws + WS_SSQ)};
        pg8::gemm_phase<EpiOut, pg8::StaticOrder, true, true>(F.lds, g, S, E);
    } SEAM(6);
    if (IN(7)) { final_norm_phase(F); }
#undef IN
#undef SEAM
}

extern "C" void kernel_launch(void* const* d_in, const int* in_sizes, int n_in, void* d_out, int out_size, void* d_ws, size_t ws_size, hipStream_t stream) {
    static int grid = 0;
    if (grid == 0) {
        if (n_in != 16 || in_sizes[0] != M * DM || out_size != M * DM || ws_size < WS_END) { fprintf(stderr, "kernel_launch: unexpected shapes (n_in %d, in0 %d, out %d, ws %zu)\n", n_in, n_in > 0 ? in_sizes[0] : -1, out_size, ws_size); grid = -1; return; }
        int dev = 0, cus = 0, per_cu = 0;
        if (hipGetDevice(&dev) != hipSuccess || hipDeviceGetAttribute(&cus, hipDeviceAttributeMultiprocessorCount, dev) != hipSuccess) { grid = -1; return; }
        if (hipFuncSetAttribute((const void*)hymba_fwd, hipFuncAttributeMaxDynamicSharedMemorySize, LDS_BYTES) != hipSuccess) { grid = -1; return; }
        if (hipOccupancyMaxActiveBlocksPerMultiprocessor(&per_cu, (const void*)hymba_fwd, NWAVES * 64, LDS_BYTES) != hipSuccess || per_cu < 1) { fprintf(stderr, "kernel_launch: occupancy query says %d blocks per CU\n", per_cu); grid = -1; return; }
        (void)hipGetLastError();
        grid = cus;
    }
    if (grid < 0) return;
    if (hipMemsetAsync((char*)d_ws + WS_CTL, 0, CTL_ZERO_BYTES, stream) != hipSuccess) return;
    Args a{};
    for (int i = 0; i < 16; ++i) a.in[i] = (const float*)d_in[i];
    a.out = (float*)d_out; a.ws = (unsigned char*)d_ws;
    if (N_LAUNCHES == 1) { a.ph_lo = 0; a.ph_hi = NPHASE; a.li = 0; hipLaunchKernelGGL(hymba_fwd, dim3(grid), dim3(NWAVES * 64), LDS_BYTES, stream, a); }
    else for (int li = 0; li < NPHASE; ++li) { a.ph_lo = li; a.ph_hi = li + 1; a.li = 0; hipLaunchKernelGGL(hymba_fwd, dim3(grid), dim3(NWAVES * 64), LDS_BYTES, stream, a); }
}
```

```cpp
#include <hip/hip_runtime.h>
#include <cstdio>
#include <cstdint>
namespace pg8 {
#define PG8_LAS __attribute__((address_space(3)))
typedef unsigned short bf16_t;
typedef short bf16x8 __attribute__((ext_vector_type(8)));
typedef float f32x4 __attribute__((ext_vector_type(4)));
typedef unsigned u32x4 __attribute__((ext_vector_type(4)));
constexpr int BM = 256, BK = 64, HALF = 128, HTB = HALF * BK * 2  , STAGE_BYTES = 8 * HTB, NXCD = 8, WGM = 8;

__host__ __device__ __forceinline__ int lds_byte(int r, int c) { const int st = (r >> 4) * 2 + (c >> 5), rr = r & 15, cc = c & 31, ob = rr * 64 + cc * 2; return st * 1024 + (ob ^ (((ob >> 9) & 1) << 5)); }
__host__ __device__ __forceinline__ void stage_rc(int b, int& R, int& C) { const int st = b / 1024, sb = b % 1024, swz = sb ^ (((sb >> 9) & 1) << 5); R = (st >> 1) * 16 + swz / 64; C = (st & 1) * 32 + (swz % 64) / 2; }
__host__ __device__ __forceinline__ int perm32(int rho) { const int n = rho >> 4, i = rho & 15; return 8 * (i >> 2) + 4 * n + (i & 3); }

struct Unit { int pm, pn; };
struct Gemm { const bf16_t* A; const bf16_t* Bt; int M, N, K; };

struct StaticOrder {
    int nM, nN, nwg, G, c;
    __host__ __device__ void init(int M, int N, int G_, int c_) { nM = M / BM; nN = N / BM; nwg = nM * nN; G = G_; c = c_; }
    __host__ __device__ bool next(int i, Unit& u) const {
        const long L = (long)i * G + c; if (L >= nwg) return false;
        int wgid = (int)L; { const int q = nwg / NXCD, r = nwg % NXCD, xcd = wgid % NXCD, off = wgid / NXCD; wgid = (xcd < r ? xcd * (q + 1) : r * (q + 1) + (xcd - r) * q) + off; }
        const int nig = WGM * nN, gid = wgid / nig, fm = gid * WGM, gsz = (nM - fm) < WGM ? (nM - fm) : WGM;
        u.pm = fm + ((wgid % nig) % gsz); u.pn = (wgid % nig) / gsz; return true;
    }
    __device__ __forceinline__ void a_ready(const Unit&) const {}
    __device__ __forceinline__ void done(const Unit&) const {}
};

__device__ __forceinline__ unsigned cvt_pk_bf16(float lo, float hi) { unsigned r; asm volatile("v_cvt_pk_bf16_f32 %0, %1, %2" : "=v"(r) : "v"(lo), "v"(hi)); return r; }
typedef float f32x2 __attribute__((ext_vector_type(2)));
__device__ __forceinline__ f32x2 gelu_pk(f32x2 v) {
    const f32x2 av = __builtin_elementwise_abs(v), d = av * 0.2316418882f + 1.0f;
    f32x2 t; t.x = __builtin_amdgcn_rcpf(d.x); t.y = __builtin_amdgcn_rcpf(d.y);
    f32x2 q = t * 0.5307027145f + (-0.7265760135f); q = q * t + 0.7107068705f; q = q * t + (-0.142248368f); q = q * t + 0.127414796f; q = q * t;
    const f32x2 s = (v * v) * (-0.72134752044f);
    f32x2 e; e.x = __builtin_amdgcn_exp2f(s.x); e.y = __builtin_amdgcn_exp2f(s.y);
    const f32x2 m = v * (q * e), r = v - m;
    f32x2 o; o.x = v.x < 0.f ? m.x : r.x; o.y = v.y < 0.f ? m.y : r.y; return o;
}

template <int ACT  > struct EpiBf16 {
    static constexpr bool PERM = true, AFTER_DRAIN = false; static_assert(ACT == 0 || ACT == 1, "EpiBf16: ACT is 0 (none) or 1 (gelu_pk)");
    bf16_t* O; int ldc; const float* bias; int split_cols; size_t split_stride; float scale0;
    __device__ __forceinline__ void operator()(const f32x4 (&acc)[2][2][4][2], const Unit& u, int wr, int wc, int fr, int fq) const {
        const int row0 = u.pm * BM + wr * 64 + fr; int colt = u.pn * BM; bf16_t* base = O;
        float sc = 1.f; if (split_cols) { const int t = colt / split_cols; base += (size_t)t * split_stride; colt -= t * split_cols; if (t == 0) sc = scale0; }
        const int col0 = colt + wc * 32 + 8 * fq, bcol0 = u.pn * BM + wc * 32 + 8 * fq;
        f32x4 bv[2][2];
#pragma unroll
        for (int bj = 0; bj < 2; ++bj)
#pragma unroll
            for (int n = 0; n < 2; ++n) bv[bj][n] = bias ? *(const f32x4*)(bias + bcol0 + bj * HALF + 4 * n) : (f32x4){0.f, 0.f, 0.f, 0.f};
#pragma unroll
        for (int ai = 0; ai < 2; ++ai)
#pragma unroll
            for (int m = 0; m < 4; ++m) { bf16_t* rowp = base + (size_t)(row0 + ai * HALF + m * 16) * ldc + col0;
#pragma unroll
                for (int bj = 0; bj < 2; ++bj) { f32x4 v0 = acc[ai][bj][m][0] + bv[bj][0], v1 = acc[ai][bj][m][1] + bv[bj][1];
                    if (ACT == 1) { f32x2 a = gelu_pk((f32x2){v0[0], v0[1]}), b = gelu_pk((f32x2){v0[2], v0[3]}), c = gelu_pk((f32x2){v1[0], v1[1]}), d = gelu_pk((f32x2){v1[2], v1[3]});
                        v0 = (f32x4){a.x, a.y, b.x, b.y}; v1 = (f32x4){c.x, c.y, d.x, d.y}; }
                    v0 = v0 * sc; v1 = v1 * sc; u32x4 w; w.x = cvt_pk_bf16(v0[0], v0[1]); w.y = cvt_pk_bf16(v0[2], v0[3]); w.z = cvt_pk_bf16(v1[0], v1[1]); w.w = cvt_pk_bf16(v1[2], v1[3]);
                    *(u32x4*)(rowp + bj * HALF) = w; } }
    }
};


template <class Epi, class Sched, bool ALIGN_EPI = false, bool SP2 = false>
__device__ __forceinline__ void gemm_phase(PG8_LAS unsigned char* lds, const Gemm g, const Sched& S, const Epi& E) {
    const int tid = threadIdx.x, wid = __builtin_amdgcn_readfirstlane(tid >> 6), lane = tid & 63, wr = wid >> 2, wc = wid & 3, fr = lane & 15, fq = lane >> 4;
    const int K = g.K, nt = K / BK;
    unsigned voffA[2], voffB[2];
#pragma unroll
    for (int i = 0; i < 2; ++i) { int R, C; stage_rc(tid * 16 + i * 8192, R, C); const int Rb = Epi::PERM ? ((R & ~31) + perm32(R & 31)) : R;
        voffA[i] = (unsigned)(R * K + C) * 2u; voffB[i] = (unsigned)(Rb * K + C) * 2u; }
    const size_t kstep = (size_t)(BK * 2);
    const size_t hstep = (size_t)HALF * K * 2;
    const size_t tstep = 2 * hstep;
    const unsigned ldsw = (unsigned)wid * 1024u;
    const int aoff = lds_byte(wr * 64 + fr, fq * 8), boff = lds_byte(wc * 32 + fr, fq * 8);
#define PG8_SA(b, h) (((b) * 2 + (h)) * HTB)
#define PG8_SB(b, h) ((4 + (b) * 2 + (h)) * HTB)
#define PG8_STAGE(bufoff, gbase, voff) do { _Pragma("unroll") for (int _i = 0; _i < 2; ++_i) \
        __builtin_amdgcn_global_load_lds((const unsigned*)((const char*)(gbase) + (voff)[_i]), (PG8_LAS unsigned*)(lds + (bufoff) + ldsw + _i * 8192), 16, 0, 0); } while (0)
#define PG8_LDA(dst, b, h) do { _Pragma("unroll") for (int m = 0; m < 4; ++m) _Pragma("unroll") for (int k = 0; k < 2; ++k) dst[m][k] = *(const PG8_LAS bf16x8*)(lds + PG8_SA(b, h) + aoff + m * 2048 + k * 1024); } while (0)
#define PG8_LDB(dst, b, h) do { _Pragma("unroll") for (int n = 0; n < 2; ++n) _Pragma("unroll") for (int k = 0; k < 2; ++k) dst[n][k] = *(const PG8_LAS bf16x8*)(lds + PG8_SB(b, h) + boff + n * 2048 + k * 1024); } while (0)
#define PG8_MMA(ai, bj, At, Bt) do { __builtin_amdgcn_s_setprio(1); _Pragma("unroll") for (int m = 0; m < 4; ++m) _Pragma("unroll") for (int n = 0; n < 2; ++n) _Pragma("unroll") for (int k = 0; k < 2; ++k) \
        acc[ai][bj][m][n] = __builtin_amdgcn_mfma_f32_16x16x32_bf16(Bt[n][k], At[m][k], acc[ai][bj][m][n], 0, 0, 0); __builtin_amdgcn_s_setprio(0); } while (0)
#define PG8_WAIT_V(n) asm volatile("s_waitcnt vmcnt(" #n ")" ::: "memory")
#define PG8_WAIT_L(n) asm volatile("s_waitcnt lgkmcnt(" #n ")" ::: "memory")
#define PG8_BAR __builtin_amdgcn_s_barrier()
#define PG8_SCHED __builtin_amdgcn_sched_barrier(0)
    Unit cur, nxt; int ui = 0;
    if (!S.next(0, cur)) return;
    f32x4 acc[2][2][4][2];
#pragma unroll
    for (int a = 0; a < 2; ++a)
#pragma unroll
        for (int b = 0; b < 2; ++b)
#pragma unroll
            for (int m = 0; m < 4; ++m)
#pragma unroll
                for (int n = 0; n < 2; ++n) acc[a][b][m][n] = (f32x4){0.f, 0.f, 0.f, 0.f};
    bf16x8 At[4][2], B0[2][2], B1[2][2];
    const char* cA = (const char*)g.A + (size_t)cur.pm * tstep; const char* cB = (const char*)g.Bt + (size_t)cur.pn * tstep;
    S.a_ready(cur);
    if constexpr (SP2) {
        PG8_STAGE(PG8_SB(0, 0), cB, voffB); PG8_STAGE(PG8_SB(0, 1), cB + hstep, voffB); PG8_STAGE(PG8_SA(0, 0), cA, voffA); PG8_STAGE(PG8_SA(0, 1), cA + hstep, voffA);
        if (wr == 1) PG8_BAR;
        PG8_WAIT_V(2); PG8_BAR;
        PG8_STAGE(PG8_SB(1, 0), cB + kstep, voffB); PG8_STAGE(PG8_SA(1, 0), cA + kstep, voffA); PG8_STAGE(PG8_SB(1, 1), cB + hstep + kstep, voffB);
        PG8_WAIT_V(6); PG8_BAR;
    } else {
        PG8_STAGE(PG8_SB(0, 0), cB, voffB); PG8_STAGE(PG8_SA(0, 0), cA, voffA); PG8_STAGE(PG8_SB(0, 1), cB + hstep, voffB); PG8_STAGE(PG8_SA(0, 1), cA + hstep, voffA);
        if (wr == 1) PG8_BAR;
        PG8_WAIT_V(4); PG8_BAR;
        PG8_STAGE(PG8_SB(1, 0), cB + kstep, voffB); PG8_STAGE(PG8_SA(1, 0), cA + kstep, voffA); PG8_STAGE(PG8_SB(1, 1), cB + hstep + kstep, voffB);
        PG8_WAIT_V(6); PG8_BAR;
    }
    for (;;) {
        const bool has_next = S.next(ui + 1, nxt);
        const char* nA = has_next ? (const char*)g.A + (size_t)nxt.pm * tstep : cA; const char* nB = has_next ? (const char*)g.Bt + (size_t)nxt.pn * tstep : cB;
        for (int t = 0; t < nt; t += 2) {
            const bool last = (t == nt - 2);
            const char* a1 = cA + (size_t)(t + 1) * kstep;
            const char* a2 = last ? nA : cA + (size_t)(t + 2) * kstep; const char* b2 = last ? nB : cB + (size_t)(t + 2) * kstep;
            const char* a3 = a2 + kstep; const char* b3 = b2 + kstep;
            if (last && has_next) S.a_ready(nxt);
            if constexpr (SP2) {
            PG8_LDB(B0, 0, 0); PG8_LDB(B1, 0, 1); PG8_SCHED; PG8_LDA(At, 0, 0); PG8_STAGE(PG8_SA(1, 1), a1 + hstep, voffA);
            PG8_WAIT_V(8); PG8_WAIT_L(0); PG8_BAR; PG8_MMA(0, 0, At, B0); PG8_MMA(0, 1, At, B1); PG8_BAR; PG8_SCHED;
            PG8_LDA(At, 0, 1); PG8_STAGE(PG8_SB(0, 0), b2, voffB); PG8_STAGE(PG8_SB(0, 1), b2 + hstep, voffB); PG8_STAGE(PG8_SA(0, 0), a2, voffA);
            PG8_WAIT_V(8); PG8_WAIT_L(0); PG8_BAR; PG8_MMA(1, 0, At, B0); PG8_MMA(1, 1, At, B1); PG8_BAR; PG8_SCHED;
            PG8_LDB(B0, 1, 0); PG8_LDB(B1, 1, 1); PG8_SCHED; PG8_LDA(At, 1, 0); PG8_STAGE(PG8_SA(0, 1), a2 + hstep, voffA);
            PG8_WAIT_V(8); PG8_WAIT_L(0); PG8_BAR; PG8_MMA(0, 0, At, B0); PG8_MMA(0, 1, At, B1); PG8_BAR; PG8_SCHED;
            PG8_LDA(At, 1, 1); PG8_STAGE(PG8_SB(1, 0), b3, voffB); PG8_STAGE(PG8_SB(1, 1), b3 + hstep, voffB); PG8_STAGE(PG8_SA(1, 0), a3, voffA);
            PG8_WAIT_V(8); PG8_WAIT_L(0); PG8_BAR; PG8_MMA(1, 0, At, B0); PG8_MMA(1, 1, At, B1); PG8_BAR; PG8_SCHED;
            } else {
            PG8_LDB(B0, 0, 0); PG8_SCHED; PG8_LDA(At, 0, 0); PG8_STAGE(PG8_SA(1, 1), a1 + hstep, voffA);
            PG8_WAIT_L(8); PG8_BAR; PG8_WAIT_L(0); PG8_MMA(0, 0, At, B0); PG8_BAR; PG8_SCHED;
            PG8_LDB(B1, 0, 1); PG8_STAGE(PG8_SB(0, 0), b2, voffB);
            PG8_BAR; PG8_WAIT_L(0); PG8_MMA(0, 1, At, B1); PG8_BAR;
            PG8_LDA(At, 0, 1); PG8_STAGE(PG8_SA(0, 0), a2, voffA);
            PG8_BAR; PG8_WAIT_L(0); PG8_MMA(1, 0, At, B0); PG8_BAR; PG8_SCHED;
            PG8_STAGE(PG8_SB(0, 1), b2 + hstep, voffB);
            PG8_WAIT_V(6); PG8_BAR; PG8_MMA(1, 1, At, B1); PG8_BAR;
            PG8_LDB(B0, 1, 0); PG8_SCHED; PG8_LDA(At, 1, 0); PG8_STAGE(PG8_SA(0, 1), a2 + hstep, voffA);
            PG8_WAIT_L(8); PG8_BAR; PG8_WAIT_L(0); PG8_MMA(0, 0, At, B0); PG8_BAR; PG8_SCHED;
            PG8_LDB(B1, 1, 1); PG8_STAGE(PG8_SB(1, 0), b3, voffB);
            PG8_BAR; PG8_WAIT_L(0); PG8_MMA(0, 1, At, B1); PG8_BAR;
            PG8_LDA(At, 1, 1); PG8_STAGE(PG8_SA(1, 0), a3, voffA);
            PG8_BAR; PG8_WAIT_L(0); PG8_MMA(1, 0, At, B0); PG8_BAR; PG8_SCHED;
            PG8_STAGE(PG8_SB(1, 1), b3 + hstep, voffB);
            PG8_WAIT_V(6); PG8_BAR; PG8_MMA(1, 1, At, B1); PG8_BAR;
            }
        }
        if constexpr (ALIGN_EPI) { if (wr == 0) PG8_BAR; }
        if constexpr (!Epi::AFTER_DRAIN) { E(acc, cur, wr, wc, fr, fq); S.done(cur); }
        if (!has_next) break;
#pragma unroll
        for (int a = 0; a < 2; ++a)
#pragma unroll
            for (int b = 0; b < 2; ++b)
#pragma unroll
                for (int m = 0; m < 4; ++m)
#pragma unroll
                    for (int n = 0; n < 2; ++n) acc[a][b][m][n] = (f32x4){0.f, 0.f, 0.f, 0.f};
        cur = nxt; cA = nA; cB = nB; ++ui;
        if constexpr (ALIGN_EPI) { if (wr == 1) PG8_BAR; }
    }
    PG8_WAIT_V(0);
    if constexpr (!ALIGN_EPI) { if (wr == 0) PG8_BAR; }
    PG8_BAR;
    if constexpr (Epi::AFTER_DRAIN) { E.fused(acc, cur, wr, wc, fr, fq, lds, wid, lane); S.done(cur); }
#undef PG8_SA
#undef PG8_SB
#undef PG8_STAGE
#undef PG8_LDA
#undef PG8_LDB
#undef PG8_MMA
#undef PG8_WAIT_V
#undef PG8_WAIT_L
#undef PG8_BAR
#undef PG8_SCHED
}
}
#define GAS __attribute__((address_space(1)))
#define LAS __attribute__((address_space(3)))
typedef unsigned short bf16;
typedef unsigned v4u __attribute__((ext_vector_type(4)));
typedef float f32x4 __attribute__((ext_vector_type(4)));
typedef short bf16x8 __attribute__((ext_vector_type(8)));
typedef GAS unsigned gu32;
typedef GAS unsigned long long gu64;
#define RLX_AGENT __ATOMIC_RELAXED, __HIP_MEMORY_SCOPE_AGENT
#define LDS_WAIT() asm volatile("s_waitcnt lgkmcnt(0)" ::: "memory")
#define VM_WAIT() asm volatile("s_waitcnt vmcnt(0)" ::: "memory")
__device__ __forceinline__ unsigned long long rt() { return __builtin_amdgcn_s_memrealtime(); }
__device__ __forceinline__ unsigned f2bf(float f) { unsigned u = __builtin_bit_cast(unsigned, f); return (u + 0x7fffu + ((u >> 16) & 1u)) >> 16; }
__device__ __forceinline__ unsigned pk2(float lo, float hi) { return f2bf(lo) | (f2bf(hi) << 16); }

#define XB_TMO      128
#define XB_XCNT(j)  (256  + 64 * (j))
#define XB_XSUB(j)  (1280 + 64 * (j))
#define XB_XGEN(j)  (2304 + 64 * (j))
#define XB_TOP      3328
#define XB_TOPGEN   3392
#define XCD_BAR_WORDS 3456
#define XB_SPIN_CAP (1u << 18)

__device__ __forceinline__ unsigned xb_ld(unsigned* p)              { return __hip_atomic_load(p, __ATOMIC_RELAXED, __HIP_MEMORY_SCOPE_AGENT); }
__device__ __forceinline__ unsigned xb_add(unsigned* p, unsigned v) { return __hip_atomic_fetch_add(p, v, __ATOMIC_RELAXED, __HIP_MEMORY_SCOPE_AGENT); }
__device__ __forceinline__ unsigned xb_xcc_id() { return (unsigned)__builtin_amdgcn_s_getreg((3 << 11) | 20) & 0xFu; }
#define XB_SPIN(cond, bar) do { unsigned _sp = 0; while (cond) { __builtin_amdgcn_s_sleep(1); \
    if ((++_sp & 255u) == 0u) { if (xb_ld(&(bar)[XB_TMO])) break; if (_sp > XB_SPIN_CAP) { atomicAdd(&(bar)[XB_TMO], 1u); break; } } } } while (0)

struct XcdBarrier {
    unsigned* bar; unsigned x;
    volatile LAS unsigned* st;
};

__device__ __forceinline__ XcdBarrier xcd_barrier_post(unsigned* bar, volatile LAS unsigned* st) {
    XcdBarrier b; b.bar = bar; b.x = xb_xcc_id(); b.st = st;
    if (threadIdx.x == 0) (void)xb_add(&bar[XB_XCNT(b.x)], 1u);
    return b;
}
__device__ __forceinline__ void xcd_barrier_complete(unsigned* bar, unsigned x, unsigned& nloc, unsigned& nx) {
    const unsigned G = gridDim.x * gridDim.y * gridDim.z;
    unsigned sum, cnt, mine, sp = 0u;
    for (;;) {
        sum = 0u; cnt = 0u; mine = 0u;
#pragma unroll
        for (unsigned j = 0; j < 16; ++j) { const unsigned c = xb_ld(&bar[XB_XCNT(j)]); sum += c; cnt += (c > 0u) ? 1u : 0u; mine = (j == x) ? c : mine; }
        if (sum == G) break;
        __builtin_amdgcn_s_sleep(1);
        if ((++sp & 255u) == 0u) { if (xb_ld(&bar[XB_TMO])) break; if (sp > XB_SPIN_CAP) { atomicAdd(&bar[XB_TMO], 1u); break; } }
    }
    nloc = mine > 0u ? mine : 1u; nx = cnt > 0u ? cnt : 1u;
}

__device__ __forceinline__ void xcd_barrier(const XcdBarrier& b) {
    asm volatile("s_waitcnt vmcnt(0)" ::: "memory");
    __syncthreads();
    if (threadIdx.x == 0) {
        unsigned* bar = b.bar;
        __builtin_amdgcn_s_waitcnt(0);
        unsigned nloc = b.st[0], nx = b.st[1];
        if (nloc == 0u) { xcd_barrier_complete(bar, b.x, nloc, nx); b.st[0] = nloc; b.st[1] = nx; }
        const unsigned old = xb_add(&bar[XB_XSUB(b.x)], 1u);
        const unsigned gen = old / nloc;
        if (old + 1u == (gen + 1u) * nloc) {
            __builtin_amdgcn_fence(__ATOMIC_RELEASE, "agent");
            asm volatile("s_waitcnt vmcnt(0)" ::: "memory");
            const unsigned og = xb_add(&bar[XB_TOP], 1u);
            const unsigned tg = og / nx;
            if (og + 1u == (tg + 1u) * nx) xb_add(&bar[XB_TOPGEN], 1u);
            else XB_SPIN(xb_ld(&bar[XB_TOPGEN]) == tg, bar);
            __builtin_amdgcn_fence(__ATOMIC_ACQUIRE, "agent");
            xb_add(&bar[XB_XGEN(b.x)], 1u);
            asm volatile("s_waitcnt vmcnt(0)" ::: "memory");
        } else {
            XB_SPIN(xb_ld(&bar[XB_XGEN(b.x)]) == gen, bar);
            __builtin_amdgcn_fence(__ATOMIC_ACQUIRE, "agent");
            asm volatile("s_waitcnt vmcnt(0)" ::: "memory");
        }
    }
    __syncthreads();
}

constexpr int NWAVES = 8;
#ifndef MK_N_LAUNCHES
#define MK_N_LAUNCHES 1
#endif
constexpr int NPHASE = 10;
constexpr int N_LAUNCHES = MK_N_LAUNCHES;

constexpr int BATCH = 2, SEQ = 8192, DM = 2048, M = BATCH * SEQ, NH = 16, HD = 64;
constexpr int N1 = 8704, IN_W = 8480, NLORA = 3072, KLORA = 384;
constexpr float NORM_EPS = 1e-5f, LNX_EPS = 64e-5f;
constexpr float C2Q = 0.125f * 1.4426950408889634f;

constexpr size_t MiB = 1u << 20;
constexpr size_t WS_CTL = 0, CTL_ZERO_BYTES = 1 * MiB;
constexpr size_t WS_SSQ = 1 * MiB;
constexpr size_t WS_COS = 2 * MiB, WS_SIN = 3 * MiB;
constexpr size_t WS_BTL = 4 * MiB;
constexpr size_t WS_BT2 = 8 * MiB;
constexpr size_t WS_BT1 = 16 * MiB;
constexpr size_t WS_XN = 50 * MiB;
constexpr size_t WS_OP = 16 * MiB;
constexpr size_t WS_XL = 16 * MiB;
constexpr size_t WS_SA = 114 * MiB;
constexpr size_t WS_SB = 242 * MiB;
constexpr size_t WS_SC = 338 * MiB;
constexpr size_t WS_SD = 370 * MiB;
constexpr size_t WS_MIX = 386 * MiB;
constexpr size_t WS_AL = 450 * MiB;
constexpr size_t WS_LSE = 462 * MiB;
constexpr size_t WS_END = 512 * MiB;
constexpr int CW_BAR = 4096;

constexpr int RING_BYTES = 131072, LDSCTL_OFF = RING_BYTES, MISC_OFF = LDSCTL_OFF + 320, LDS_BYTES = 147456;

typedef float f32x16 __attribute__((ext_vector_type(16)));
typedef short s16x4 __attribute__((ext_vector_type(4)));
typedef unsigned u32x2 __attribute__((ext_vector_type(2)));

__device__ __forceinline__ float wave_sum(float v) {
#pragma unroll
    for (int o = 1; o < 64; o <<= 1) v += __shfl_xor(v, o);
    return v;
}
__device__ __forceinline__ float bf2f(unsigned short b) { return __builtin_bit_cast(float, (unsigned)b << 16); }
__device__ __forceinline__ float bflo(unsigned w) { return __builtin_bit_cast(float, w << 16); }
__device__ __forceinline__ float bfhi(unsigned w) { return __builtin_bit_cast(float, w & 0xffff0000u); }
__device__ __forceinline__ float sigmoidf_(float x) { return __builtin_amdgcn_rcpf(1.0f + __expf(-x)); }
__device__ __forceinline__ float siluf_(float x) { return x * sigmoidf_(x); }
__device__ __forceinline__ void unpack8(const v4u w, float (&f)[8]) {
    f[0] = bflo(w.x); f[1] = bfhi(w.x); f[2] = bflo(w.y); f[3] = bfhi(w.y); f[4] = bflo(w.z); f[5] = bfhi(w.z); f[6] = bflo(w.w); f[7] = bfhi(w.w);
}
__device__ __forceinline__ v4u pack8(const float (&f)[8]) { v4u w; w.x = pk2(f[0], f[1]); w.y = pk2(f[2], f[3]); w.z = pk2(f[4], f[5]); w.w = pk2(f[6], f[7]); return w; }
__device__ __forceinline__ float red8(float x) {
    x += __builtin_bit_cast(float, __builtin_amdgcn_update_dpp(0, __builtin_bit_cast(int, x), 0x141, 0xf, 0xf, true));
    x += __builtin_bit_cast(float, __builtin_amdgcn_update_dpp(0, __builtin_bit_cast(int, x), 0xB1, 0xf, 0xf, true));
    x += __builtin_bit_cast(float, __builtin_amdgcn_update_dpp(0, __builtin_bit_cast(int, x), 0x4E, 0xf, 0xf, true));
    return x;
}

struct Frame {
    LAS unsigned char* lds;
    int tid, lane, wave, vcu, G;
    const float *x, *norm_g, *w_in, *shift_mu, *w0, *w2, *a0, *a2, *g2, *k_k, *k_a, *r_k, *lnx_g, *lnx_b, *w_out, *final_g;
    float* out; unsigned char* ws;
};

__device__ __forceinline__ int gemm1_row_of_col(int o) {
    if (o < 2048) { const int d = o & 63, base = o - d; return base + (d < 32 ? 8 * (d >> 2) + (d & 3) : 8 * ((d - 32) >> 2) + 4 + (d & 3)); }
    if (o < 7168) return o;
    if (o < 7456) return o + 1024;
    return o - 288;
}
template <bool MAP>
__device__ __forceinline__ void transpose_item(const float* W, int K, int N, bf16* WT, LAS float* scr, int item, int lane) {
    const int nblk = N / 32, kb = item / nblk, nb = item % nblk, k0 = 64 * kb, n0 = 32 * nb;
#pragma unroll 8
    for (int i = 0; i < 32; ++i) { const int kk = 2 * i + (lane >> 5); scr[kk * 33 + (lane & 31)] = W[(size_t)(k0 + kk) * N + n0 + (lane & 31)]; }
    LDS_WAIT(); asm volatile("" ::: "memory");
    const int c = lane & 7;
#pragma unroll
    for (int j = 0; j < 4; ++j) { const int n = (lane >> 3) + 8 * j; const LAS float* s = scr + (8 * c) * 33 + n;
        v4u o; o.x = pk2(s[0 * 33], s[1 * 33]); o.y = pk2(s[2 * 33], s[3 * 33]); o.z = pk2(s[4 * 33], s[5 * 33]); o.w = pk2(s[6 * 33], s[7 * 33]);
        const int row = MAP ? gemm1_row_of_col(n0 + n) : (n0 + n);
        *(GAS v4u*)(WT + (size_t)row * K + k0 + 8 * c) = o; }
    LDS_WAIT(); asm volatile("" ::: "memory");
}
__device__ __forceinline__ void rms_row_to_bf16(const float* xrow, const float* g, bf16* orow, int lane) {
    const GAS f32x4* xr = (const GAS f32x4*)xrow + lane; const GAS f32x4* gr = (const GAS f32x4*)g + lane;
    f32x4 v[8]; float s = 0.f;
#pragma unroll
    for (int j = 0; j < 8; ++j) { v[j] = xr[64 * j]; s += (v[j].x * v[j].x + v[j].y * v[j].y) + (v[j].z * v[j].z + v[j].w * v[j].w); }
    const float rs = 1.0f / sqrtf(wave_sum(s) * (1.0f / DM) + NORM_EPS);
    GAS u32x2* o8 = (GAS u32x2*)orow + lane;
#pragma unroll
    for (int j = 0; j < 8; ++j) { const f32x4 gv = gr[64 * j]; u32x2 w; w.x = pk2(v[j].x * rs * gv.x, v[j].y * rs * gv.y); w.y = pk2(v[j].z * rs * gv.z, v[j].w * rs * gv.w); o8[64 * j] = w; }
}
__device__ __forceinline__ void p0_prologue(Frame& F) {
    LAS float* scr = (LAS float*)(F.lds + F.wave * 16384);
    const int gw = F.vcu * NWAVES + F.wave, NGW = F.G * NWAVES;
    const int gt = gw * 64 + F.lane, NGT = NGW * 64;
    bf16* BT1 = (bf16*)(F.ws + WS_BT1); bf16* BT2 = (bf16*)(F.ws + WS_BT2); bf16* BTL = (bf16*)(F.ws + WS_BTL); bf16* XN = (bf16*)(F.ws + WS_XN);
    constexpr int I_1 = (DM / 64) * (IN_W / 32), I_2 = (DM / 64) * (DM / 32);
    for (int it = gw; it < I_1 + I_2; it += NGW) {
        if (it < I_1) transpose_item<true>(F.w_in, DM, IN_W, BT1, scr, it, F.lane);
        else transpose_item<false>(F.w_out, DM, DM, BT2, scr, it - I_1, F.lane);
    }
    for (int i = gt; i < (N1 - IN_W) * DM / 8; i += NGT) ((GAS v4u*)(BT1 + (size_t)IN_W * DM))[i] = (v4u){0u, 0u, 0u, 0u};
    for (int i = gt; i < KLORA * 1024; i += NGT) { const int k = i >> 10, ch = i & 1023;
        const float vw = (k < 64) ? F.w2[k * 1024 + ch] : 0.f, va = (k >= 64 && k < 128) ? F.a2[(k - 64) * 1024 + ch] : 0.f, vg = (k >= 128 && k < 288) ? F.g2[(k - 128) * 1024 + ch] : 0.f;
        BTL[(size_t)ch * KLORA + k] = (bf16)f2bf(vw); BTL[(size_t)(1024 + ch) * KLORA + k] = (bf16)f2bf(va); BTL[(size_t)(2048 + ch) * KLORA + k] = (bf16)f2bf(vg); }
    { float* ct = (float*)(F.ws + WS_COS); float* st = (float*)(F.ws + WS_SIN);
      for (int i = gt; i < SEQ * 32; i += NGT) { const int pos = i >> 5, fi = i & 31;
          const double rev = (double)pos * exp2(-(double)fi * (13.287712379549449 / 32.0)) * 0.15915494309189535;
          const float fr = (float)(rev - floor(rev));
          ct[i] = __builtin_amdgcn_cosf(fr); st[i] = __builtin_amdgcn_sinf(fr); } }
    { float* ssq = (float*)(F.ws + WS_SSQ); for (int i = gt; i < M; i += NGT) ssq[i] = 0.f; }
    for (int m = gw; m < M; m += NGW) rms_row_to_bf16(F.x + (size_t)m * DM, F.norm_g, XN + (size_t)m * DM, F.lane);
}

struct EpiProj {
    static constexpr bool PERM = true, AFTER_DRAIN = false;
    pg8::bf16_t *SA, *SB, *SC, *SD; const float* cosT; const float* sinT;
    __device__ __forceinline__ void operator()(const pg8::f32x4 (&acc)[2][2][4][2], const pg8::Unit& u, int wr, int wc, int fr, int fq) const {
        const int pn = u.pn; pg8::bf16_t* base; int ld, colt, kind;
        if (pn < 16) { base = SA; ld = 4096; colt = 256 * pn; kind = pn < 4 ? 0 : pn < 8 ? 1 : pn < 12 ? 2 : 3; }
        else if (pn < 28) { base = SB; ld = 3072; colt = 256 * (pn - 16); kind = 2; }
        else if (pn < 32) { base = SC; ld = 1024; colt = 256 * (pn - 28); kind = 3; }
        else { base = SD; ld = 512; colt = 256 * (pn - 32); kind = 2; }
        const int row0 = u.pm * 256 + wr * 64 + fr, col0 = colt + wc * 32 + 8 * fq, e4 = 4 * (4 * (wc & 1) + fq);
#pragma unroll
        for (int ai = 0; ai < 2; ++ai)
#pragma unroll
            for (int m = 0; m < 4; ++m) { const int row = row0 + ai * 128 + m * 16; pg8::bf16_t* rowp = base + (size_t)row * ld + col0;
                pg8::f32x4 cs = {1.f, 1.f, 1.f, 1.f}, sn = {0.f, 0.f, 0.f, 0.f};
                if (kind <= 1) { const int pos = row & (SEQ - 1); cs = *(const pg8::f32x4*)(cosT + pos * 32 + e4); sn = *(const pg8::f32x4*)(sinT + pos * 32 + e4); }
#pragma unroll
                for (int bj = 0; bj < 2; ++bj) { pg8::f32x4 v0 = acc[ai][bj][m][0], v1 = acc[ai][bj][m][1];
                    if (kind <= 1) { const pg8::f32x4 o0 = v0 * cs - v1 * sn, o1 = v1 * cs + v0 * sn; const float s = kind == 0 ? C2Q : 1.0f; v0 = o0 * s; v1 = o1 * s; }
                    else if (kind == 3) {
#pragma unroll
                        for (int i = 0; i < 4; ++i) { v0[i] = siluf_(v0[i]); v1[i] = siluf_(v1[i]); } }
                    pg8::u32x4 w; w.x = pg8::cvt_pk_bf16(v0[0], v0[1]); w.y = pg8::cvt_pk_bf16(v0[2], v0[3]); w.z = pg8::cvt_pk_bf16(v1[0], v1[1]); w.w = pg8::cvt_pk_bf16(v1[2], v1[3]);
                    *(pg8::u32x4*)(rowp + bj * 128) = w; } }
    }
};
struct EpiOut {
    static constexpr bool PERM = false, AFTER_DRAIN = false;
    const float* x; float* out; float* ssq;
    __device__ __forceinline__ void operator()(const pg8::f32x4 (&acc)[2][2][4][2], const pg8::Unit& u, int wr, int wc, int fr, int fq) const {
        const int row0 = u.pm * 256 + wr * 64 + fr, col0 = u.pn * 256 + wc * 32 + 4 * fq;
#pragma unroll
        for (int ai = 0; ai < 2; ++ai)
#pragma unroll
            for (int m = 0; m < 4; ++m) { const int row = row0 + ai * 128 + m * 16; const size_t off = (size_t)row * DM + col0; float s = 0.f;
#pragma unroll
                for (int bj = 0; bj < 2; ++bj)
#pragma unroll
                    for (int n = 0; n < 2; ++n) { const pg8::f32x4 y = *(const pg8::f32x4*)(x + off + bj * 128 + n * 16) + acc[ai][bj][m][n];
                        *(pg8::f32x4*)(out + off + bj * 128 + n * 16) = y; s += (y[0] * y[0] + y[1] * y[1]) + (y[2] * y[2] + y[3] * y[3]); }
                s += __shfl_xor(s, 16); s += __shfl_xor(s, 32);
                if (fq == 0) atomicAdd(ssq + row, s); }
    }
};

constexpr int ATT_VP = 192;
constexpr int ATT_WLDS = 32 * ATT_VP + 4096 + 256;
__device__ __forceinline__ int crow(int r, int hi) { return (r & 3) + 8 * (r >> 2) + 4 * hi; }
__device__ __forceinline__ s16x4 vtr(const LAS unsigned char* p) { return __builtin_bit_cast(s16x4, __builtin_amdgcn_ds_read_tr16_b64_v4i16((LAS s16x4*)p)); }

__device__ __forceinline__ void attn_item(const bf16* SA, int dil, int b, int h, int r, int m0, bf16* Op, float* Lp, LAS unsigned char* wl, int lane) {
    const int q32 = lane & 31, hi = lane >> 5;
    const size_t tokb = (size_t)b * SEQ;
    const bf16* qrow = SA + (tokb + (size_t)(m0 + q32) * dil + r) * 4096 + h * 64;
    bf16x8 qf[4];
#pragma unroll
    for (int s = 0; s < 4; ++s) qf[s] = *(const bf16x8*)(qrow + 16 * s + 8 * hi);
    const int tmin = m0 >= 128 ? 0 : (128 - m0) >> 5;
    f32x16 sc[5];
#pragma unroll
    for (int t = 0; t < 5; ++t) {
        if (t < tmin) {
#pragma unroll
            for (int i = 0; i < 16; ++i) sc[t][i] = -INFINITY;
        } else {
            const bf16* krow = SA + (tokb + (size_t)(m0 - 128 + 32 * t + q32) * dil + r) * 4096 + 1024 + h * 64;
            bf16x8 kf[4];
#pragma unroll
            for (int s = 0; s < 4; ++s) kf[s] = *(const bf16x8*)(krow + 16 * s + 8 * hi);
            f32x16 a = {};
#pragma unroll
            for (int s = 0; s < 4; ++s) a = __builtin_amdgcn_mfma_f32_32x32x16_bf16(kf[s], qf[s], a, 0, 0, 0);
            if (t == 0) {
#pragma unroll
                for (int i = 0; i < 16; ++i) if (crow(i, hi) < q32) a[i] = -INFINITY;
            }
            if (t == 4) {
#pragma unroll
                for (int i = 0; i < 16; ++i) if (crow(i, hi) > q32) a[i] = -INFINITY;
            }
            sc[t] = a;
        }
    }
    float mx = -INFINITY;
#pragma unroll
    for (int t = 0; t < 5; ++t)
#pragma unroll
        for (int i = 0; i < 16; ++i) mx = fmaxf(mx, sc[t][i]);
    mx = fmaxf(mx, __shfl_xor(mx, 32));
    float l = 0.f;
#pragma unroll
    for (int t = 0; t < 5; ++t)
#pragma unroll
        for (int i = 0; i < 16; ++i) { const float p = __builtin_amdgcn_exp2f(sc[t][i] - mx); sc[t][i] = p; l += p; }
    l += __shfl_xor(l, 32);
    LAS float* wsf = (LAS float*)(wl + 32 * ATT_VP + 4096);
    if (hi == 0) wsf[q32] = __builtin_amdgcn_rcpf(l);
    f32x16 o[2]; o[0] = f32x16{}; o[1] = f32x16{};
    const LAS unsigned char* vrd = wl + (4 * hi + ((lane & 15) >> 2)) * ATT_VP + ((lane >> 4) & 1) * 32 + (lane & 3) * 8;
#pragma unroll
    for (int t = 0; t < 5; ++t) {
        if (t >= tmin) {
#pragma unroll
            for (int i = 0; i < 4; ++i) { const int row = (lane >> 3) + 8 * i, ch = lane & 7;
                const v4u v = *(const GAS v4u*)(SA + (tokb + (size_t)(m0 - 128 + 32 * t + row) * dil + r) * 4096 + 2048 + h * 64 + ch * 8);
                *(LAS v4u*)(wl + row * ATT_VP + ch * 16) = v; }
            LDS_WAIT(); asm volatile("" ::: "memory");
#pragma unroll
            for (int s2 = 0; s2 < 2; ++s2) {
                v4u pw; pw.x = pk2(sc[t][8 * s2 + 0], sc[t][8 * s2 + 1]); pw.y = pk2(sc[t][8 * s2 + 2], sc[t][8 * s2 + 3]); pw.z = pk2(sc[t][8 * s2 + 4], sc[t][8 * s2 + 5]); pw.w = pk2(sc[t][8 * s2 + 6], sc[t][8 * s2 + 7]);
                const bf16x8 pa = __builtin_bit_cast(bf16x8, pw);
#pragma unroll
                for (int db = 0; db < 2; ++db) {
                    const s16x4 lo = vtr(vrd + (16 * s2) * ATT_VP + db * 64), hh = vtr(vrd + (16 * s2 + 8) * ATT_VP + db * 64);
                    const bf16x8 vb = {lo[0], lo[1], lo[2], lo[3], hh[0], hh[1], hh[2], hh[3]};
                    o[db] = __builtin_amdgcn_mfma_f32_32x32x16_bf16(pa, vb, o[db], 0, 0, 0);
                }
            }
            LDS_WAIT(); asm volatile("" ::: "memory");
        }
    }
    LAS bf16* stg = (LAS bf16*)(wl + 32 * ATT_VP);
#pragma unroll
    for (int i = 0; i < 16; ++i) { const int q = crow(i, hi); const float li = wsf[q];
        stg[q * 64 + q32] = (bf16)f2bf(o[0][i] * li); stg[q * 64 + 32 + q32] = (bf16)f2bf(o[1][i] * li); }
    LDS_WAIT(); asm volatile("" ::: "memory");
#pragma unroll
    for (int i = 0; i < 4; ++i) { const int row = i * 8 + (lane >> 3), ch = lane & 7; const v4u v = *(const LAS v4u*)(stg + row * 64 + ch * 8);
        *(GAS v4u*)(Op + (tokb + (size_t)(m0 + row) * dil + r) * 1024 + h * 64 + ch * 8) = v; }
    if (hi == 0) Lp[(tokb + (size_t)(m0 + q32) * dil + r) * 16 + h] = mx + __builtin_amdgcn_logf(l);
    LDS_WAIT(); asm volatile("" ::: "memory");
}
__device__ __forceinline__ void attn_phase(Frame& F) {
    const bf16* SA = (const bf16*)(F.ws + WS_SA);
    LAS unsigned char* wl = F.lds + F.wave * ATT_WLDS;
    const int gw = F.vcu * NWAVES + F.wave, NGW = F.G * NWAVES;
    for (int it = gw; it < 3 * 8192; it += NGW) {
        const int pat = it >> 13, rem = it & 8191, bh = rem >> 8, tile = rem & 255;
        const int dil = pat == 0 ? 1 : pat == 1 ? 4 : 16, tpc = 256 / dil;
        const int r = tile / tpc, m0 = 32 * (tile % tpc);
        attn_item(SA, dil, bh >> 4, bh & 15, r, m0, (bf16*)(F.ws + WS_OP) + (size_t)pat * M * 1024, (float*)(F.ws + WS_LSE) + (size_t)pat * M * 16, wl, F.lane);
    }
}
__device__ __forceinline__ void lora_act_phase(Frame& F) {
    const bf16* SD = (const bf16*)(F.ws + WS_SD); bf16* AL = (bf16*)(F.ws + WS_AL);
    const int gt = (F.vcu * NWAVES + F.wave) * 64 + F.lane, NGT = F.G * NWAVES * 64;
    for (int i = gt; i < M * (KLORA / 8); i += NGT) { const int m = i / (KLORA / 8), c8 = (i % (KLORA / 8)) * 8;
        v4u o = {0u, 0u, 0u, 0u};
        if (c8 < 288) {
            float cur[8], prv[8], f[8];
            unpack8(*(const GAS v4u*)(SD + (size_t)m * 512 + c8), cur);
            if ((m & (SEQ - 1)) != 0) unpack8(*(const GAS v4u*)(SD + (size_t)(m - 1) * 512 + c8), prv);
            else {
#pragma unroll
                for (int e = 0; e < 8; ++e) prv[e] = 0.f; }
#pragma unroll
            for (int e = 0; e < 8; ++e) { const float mu = F.shift_mu[3072 + c8 + e]; const float xs = cur[e] + (prv[e] - cur[e]) * mu;
                f[e] = c8 < 64 ? tanhf(xs) : c8 < 128 ? xs : sigmoidf_(xs); }
            o = pack8(f);
        }
        *(GAS v4u*)(AL + (size_t)m * KLORA + c8) = o; }
}
__device__ __forceinline__ void combine_phase(Frame& F) {
    const bf16* SA = (const bf16*)(F.ws + WS_SA); const bf16* OP = (const bf16*)(F.ws + WS_OP); const float* LS = (const float*)(F.ws + WS_LSE); bf16* MIX = (bf16*)(F.ws + WS_MIX);
    const int gt = (F.vcu * NWAVES + F.wave) * 64 + F.lane, NGT = F.G * NWAVES * 64;
    for (int i = gt; i < M * 128; i += NGT) { const int m = i >> 7, c8 = (i & 127) * 8, h = c8 >> 6;
        const float l0 = LS[(size_t)m * 16 + h], l1 = LS[(size_t)(M + m) * 16 + h], l2 = LS[(size_t)(2 * M + m) * 16 + h];
        const float mx = fmaxf(l0, fmaxf(l1, l2));
        float w0 = __builtin_amdgcn_exp2f(l0 - mx), w1 = __builtin_amdgcn_exp2f(l1 - mx), w2 = __builtin_amdgcn_exp2f(l2 - mx);
        const float inv = 1.0f / (w0 + w1 + w2); w0 *= inv; w1 *= inv; w2 *= inv;
        float a[8], bq[8], c[8], z[8], f[8];
        unpack8(*(const GAS v4u*)(OP + (size_t)m * 1024 + c8), a); unpack8(*(const GAS v4u*)(OP + (size_t)(M + m) * 1024 + c8), bq); unpack8(*(const GAS v4u*)(OP + (size_t)(2 * M + m) * 1024 + c8), c);
        unpack8(*(const GAS v4u*)(SA + (size_t)m * 4096 + 3072 + c8), z);
#pragma unroll
        for (int e = 0; e < 8; ++e) f[e] = (w0 * a[e] + w1 * bq[e] + w2 * c[e]) * z[e];
        *(GAS v4u*)(MIX + (size_t)m * 2048 + c8) = pack8(f); }
}
__device__ __forceinline__ void rwkv_seq_phase(Frame& F) {
    if (F.vcu >= BATCH * NH) return;
    const int b = F.vcu >> 4, h = F.vcu & 15, tid = F.tid;
    const bf16* SB = (const bf16*)(F.ws + WS_SB); const bf16* SC = (const bf16*)(F.ws + WS_SC); const bf16* XL = (const bf16*)(F.ws + WS_XL); bf16* MIX = (bf16*)(F.ws + WS_MIX);
    LAS float* LR = (LAS float*)F.lds; LAS float* LW = LR + 4096; LAS float* LK = LW + 4096; LAS float* LA = LK + 4096; LAS float* LB = LA + 4096; LAS float* LV = LB + 4096; LAS float* LY = LV + 4096;
    const int tok = tid >> 3, cg = tid & 7, ch0 = h * 64 + 8 * cg;
    float mu_r[8], mu_k[8], mu_v[8], w0v[8], a0v[8], kkv[8], kav[8], rkv[8], lg[8], lb[8];
#pragma unroll
    for (int e = 0; e < 8; ++e) { mu_r[e] = F.shift_mu[ch0 + e]; mu_k[e] = F.shift_mu[1024 + ch0 + e]; mu_v[e] = F.shift_mu[2048 + ch0 + e]; w0v[e] = F.w0[ch0 + e]; a0v[e] = F.a0[ch0 + e];
        kkv[e] = F.k_k[ch0 + e]; kav[e] = F.k_a[ch0 + e]; rkv[e] = F.r_k[ch0 + e]; lg[e] = F.lnx_g[ch0 + e]; lb[e] = F.lnx_b[ch0 + e]; }
    float st[8];
#pragma unroll
    for (int e = 0; e < 8; ++e) st[e] = 0.f;
    for (int c = 0; c < SEQ / 64; ++c) {
        const size_t m = (size_t)b * SEQ + c * 64 + tok;
        {
            float r[8], k[8], v[8], pr[8], pk[8], pv[8], xw[8], xa[8];
            unpack8(*(const GAS v4u*)(SB + m * 3072 + ch0), r); unpack8(*(const GAS v4u*)(SB + m * 3072 + 1024 + ch0), k); unpack8(*(const GAS v4u*)(SB + m * 3072 + 2048 + ch0), v);
            if (c * 64 + tok != 0) { unpack8(*(const GAS v4u*)(SB + (m - 1) * 3072 + ch0), pr); unpack8(*(const GAS v4u*)(SB + (m - 1) * 3072 + 1024 + ch0), pk); unpack8(*(const GAS v4u*)(SB + (m - 1) * 3072 + 2048 + ch0), pv); }
            else {
#pragma unroll
                for (int e = 0; e < 8; ++e) { pr[e] = 0.f; pk[e] = 0.f; pv[e] = 0.f; } }
            unpack8(*(const GAS v4u*)(XL + m * 3072 + ch0), xw); unpack8(*(const GAS v4u*)(XL + m * 3072 + 1024 + ch0), xa);
            float kk[8], ss = 0.f, as[8];
#pragma unroll
            for (int e = 0; e < 8; ++e) { r[e] += (pr[e] - r[e]) * mu_r[e]; k[e] += (pk[e] - k[e]) * mu_k[e]; v[e] += (pv[e] - v[e]) * mu_v[e];
                as[e] = sigmoidf_(a0v[e] + xa[e]); kk[e] = k[e] * kkv[e]; ss += kk[e] * kk[e]; }
            ss = red8(ss); const float inv = 1.0f / fmaxf(sqrtf(ss), 1e-12f);
#pragma unroll
            for (int e = 0; e < 8; ++e) { const float kn = kk[e] * inv; const int o = tok * 64 + 8 * cg + e;
                LR[o] = r[e]; LW[o] = __expf(-0.6065306597126334f * sigmoidf_(w0v[e] + xw[e])); LK[o] = k[e] * (1.0f + (as[e] - 1.0f) * kav[e]); LA[o] = -kn; LB[o] = kn * as[e]; LV[o] = v[e]; }
        }
        __syncthreads();
        {
            const int i = tid >> 3, jo = 8 * (tid & 7);
            for (int t = 0; t < 64; ++t) {
                const f32x4 a0 = *(const LAS f32x4*)(LA + t * 64 + jo), a1 = *(const LAS f32x4*)(LA + t * 64 + jo + 4);
                float sa = (st[0] * a0[0] + st[1] * a0[1]) + (st[2] * a0[2] + st[3] * a0[3]) + (st[4] * a1[0] + st[5] * a1[1]) + (st[6] * a1[2] + st[7] * a1[3]);
                sa = red8(sa);
                const f32x4 w0_ = *(const LAS f32x4*)(LW + t * 64 + jo), w1_ = *(const LAS f32x4*)(LW + t * 64 + jo + 4);
                const f32x4 b0 = *(const LAS f32x4*)(LB + t * 64 + jo), b1 = *(const LAS f32x4*)(LB + t * 64 + jo + 4);
                const f32x4 k0 = *(const LAS f32x4*)(LK + t * 64 + jo), k1 = *(const LAS f32x4*)(LK + t * 64 + jo + 4);
                const f32x4 r0 = *(const LAS f32x4*)(LR + t * 64 + jo), r1 = *(const LAS f32x4*)(LR + t * 64 + jo + 4);
                const float vi = LV[t * 64 + i];
#pragma unroll
                for (int e = 0; e < 4; ++e) { st[e] = st[e] * w0_[e] + sa * b0[e] + vi * k0[e]; st[4 + e] = st[4 + e] * w1_[e] + sa * b1[e] + vi * k1[e]; }
                float y = (st[0] * r0[0] + st[1] * r0[1]) + (st[2] * r0[2] + st[3] * r0[3]) + (st[4] * r1[0] + st[5] * r1[1]) + (st[6] * r1[2] + st[7] * r1[3]);
                y = red8(y);
                if ((tid & 7) == 0) LY[t * 64 + i] = y;
            }
        }
        __syncthreads();
        {
            float y[8], s = 0.f, q = 0.f, bon = 0.f, g[8], z[8], f[8];
#pragma unroll
            for (int e = 0; e < 8; ++e) { y[e] = LY[tok * 64 + 8 * cg + e]; s += y[e]; }
            const float mean = red8(s) * (1.0f / 64.0f);
#pragma unroll
            for (int e = 0; e < 8; ++e) { y[e] -= mean; q += y[e] * y[e]; bon += LR[tok * 64 + 8 * cg + e] * LK[tok * 64 + 8 * cg + e] * rkv[e]; }
            const float rstd = 1.0f / sqrtf(red8(q) * (1.0f / 64.0f) + LNX_EPS); bon = red8(bon);
            unpack8(*(const GAS v4u*)(XL + m * 3072 + 2048 + ch0), g); unpack8(*(const GAS v4u*)(SC + m * 1024 + ch0), z);
#pragma unroll
            for (int e = 0; e < 8; ++e) f[e] = (y[e] * rstd * lg[e] + lb[e] + bon * LV[tok * 64 + 8 * cg + e]) * g[e] * z[e];
            *(GAS v4u*)(MIX + m * 2048 + 1024 + ch0) = pack8(f);
        }
        __syncthreads();
    }
}
__device__ __forceinline__ void final_norm_phase(Frame& F) {
    const float* ssq = (const float*)(F.ws + WS_SSQ);
    const int gw = F.vcu * NWAVES + F.wave, NGW = F.G * NWAVES;
    for (int m = gw; m < M; m += NGW) {
        const float rs = 1.0f / sqrtf(ssq[m] * (1.0f / DM) + NORM_EPS);
        GAS f32x4* yr = (GAS f32x4*)(F.out + (size_t)m * DM) + F.lane; const GAS f32x4* gr = (const GAS f32x4*)F.final_g + F.lane;
#pragma unroll
        for (int j = 0; j < 8; ++j) { const f32x4 v = yr[64 * j], g = gr[64 * j]; yr[64 * j] = v * rs * g; }
    }
}


constexpr size_t WS_PB = WS_SA;
constexpr size_t WS_QB = WS_SA + 32 * MiB;
constexpr size_t WS_GB = WS_SA + 64 * MiB;
constexpr size_t WS_YB = WS_SA + 96 * MiB;
constexpr size_t WS_HB = 465 * MiB;
constexpr int RW_PB = 144;
constexpr int RW_TA = 0, RW_TB = 9216, RW_TK = 18432, RW_TR = 27648, RW_TV = 36864, RW_MRB = 46080, RW_LAK = 55296, RW_MRK = 64512, RW_XT = 55296  ,
              RW_CL = 55296  , RW_LABF = 73728  , RW_TOT = 73728  , RW_L21 = 81920  ,
              RW_TT = 84480  , RW_R2T = 89600, RW_GC = 98816;
constexpr int RW_PS = 80;

struct RwElem { float r[8], kp[8], v[8], as[8], kn[8], lw[8]; };
__device__ __forceinline__ void rwkv_elem(const Frame& F, const bf16* SB, const bf16* XL, size_t m, bool first, int ch0, RwElem& E) {
    float pr[8], pk[8], pv[8], xw[8], xa[8], k[8];
    unpack8(*(const GAS v4u*)(SB + m * 3072 + ch0), E.r); unpack8(*(const GAS v4u*)(SB + m * 3072 + 1024 + ch0), k); unpack8(*(const GAS v4u*)(SB + m * 3072 + 2048 + ch0), E.v);
    if (!first) { unpack8(*(const GAS v4u*)(SB + (m - 1) * 3072 + ch0), pr); unpack8(*(const GAS v4u*)(SB + (m - 1) * 3072 + 1024 + ch0), pk); unpack8(*(const GAS v4u*)(SB + (m - 1) * 3072 + 2048 + ch0), pv); }
    else {
#pragma unroll
        for (int e = 0; e < 8; ++e) { pr[e] = 0.f; pk[e] = 0.f; pv[e] = 0.f; } }
    unpack8(*(const GAS v4u*)(XL + m * 3072 + ch0), xw); unpack8(*(const GAS v4u*)(XL + m * 3072 + 1024 + ch0), xa);
    float ss = 0.f, kk[8];
#pragma unroll
    for (int e = 0; e < 8; ++e) { const int ch = ch0 + e;
        E.r[e] += (pr[e] - E.r[e]) * F.shift_mu[ch]; k[e] += (pk[e] - k[e]) * F.shift_mu[1024 + ch]; E.v[e] += (pv[e] - E.v[e]) * F.shift_mu[2048 + ch];
        E.as[e] = sigmoidf_(F.a0[ch] + xa[e]); kk[e] = k[e] * F.k_k[ch]; ss += kk[e] * kk[e];
        E.lw[e] = -0.6065306597126334f * sigmoidf_(F.w0[ch] + xw[e]); E.kp[e] = k[e] * (1.0f + (E.as[e] - 1.0f) * F.k_a[ch]); }
    ss = red8(ss); const float inv = 1.0f / fmaxf(sqrtf(ss), 1e-12f);
#pragma unroll
    for (int e = 0; e < 8; ++e) E.kn[e] = kk[e] * inv;
}
__device__ __forceinline__ bf16x8 rw_row(const LAS unsigned char* tile, int pitch, int row0, int k0, int lane) {
    return *(const LAS bf16x8*)(tile + (row0 + (lane & 31)) * pitch + (k0 + 8 * (lane >> 5)) * 2); }
__device__ __forceinline__ bf16x8 rw_tr(const LAS unsigned char* tile, int pitch, int k0, int n0, int lane) {
    const LAS unsigned char* p = tile + (k0 + 8 * (lane >> 5) + ((lane & 15) >> 2)) * pitch + (n0 + 16 * ((lane >> 4) & 1) + 4 * (lane & 3)) * 2;
    const s16x4 lo = vtr(p), hi = vtr(p + 4 * pitch);
    return (bf16x8){lo[0], lo[1], lo[2], lo[3], hi[0], hi[1], hi[2], hi[3]}; }
#define RW_MFMA(a, b, c) __builtin_amdgcn_mfma_f32_32x32x16_bf16((a), (b), (c), 0, 0, 0)
__device__ __forceinline__ void rw_st_lr(LAS unsigned char* tile, int pitch, int row, int col0, const f32x16& v, int h) {
#pragma unroll
    for (int q = 0; q < 4; ++q) { u32x2 w; w.x = pk2(v[4 * q], v[4 * q + 1]); w.y = pk2(v[4 * q + 2], v[4 * q + 3]); *(LAS u32x2*)(tile + row * pitch + (col0 + 8 * q + 4 * h) * 2) = w; }
}
__device__ __forceinline__ void rw_st_lr_g(bf16* base, int pitch_el, int row, int col0, const f32x16& v, int h) {
#pragma unroll
    for (int q = 0; q < 4; ++q) { u32x2 w; w.x = pk2(v[4 * q], v[4 * q + 1]); w.y = pk2(v[4 * q + 2], v[4 * q + 3]); *(GAS u32x2*)(base + (size_t)row * pitch_el + col0 + 8 * q + 4 * h) = w; }
}


__device__ __attribute__((noinline)) void rw_inv32(const LAS float* Lb, LAS unsigned char* dst, int x31) {
    float Tr[32];
#pragma unroll
    for (int u = 0; u < 32; ++u) Tr[u] = (u == x31) ? 1.f : 0.f;
#pragma unroll
    for (int s = 30; s >= 0; --s) {
        float a0 = 0.f, a1 = 0.f, a2 = 0.f, a3 = 0.f;
#pragma unroll
        for (int c4 = (s + 1) >> 2; c4 < 8; ++c4) { const f32x4 lv = *(const LAS f32x4*)(Lb + s * 32 + 4 * c4);
            if (4 * c4 + 0 > s) a0 += Tr[4 * c4 + 0] * lv[0];
            if (4 * c4 + 1 > s) a1 += Tr[4 * c4 + 1] * lv[1];
            if (4 * c4 + 2 > s) a2 += Tr[4 * c4 + 2] * lv[2];
            if (4 * c4 + 3 > s) a3 += Tr[4 * c4 + 3] * lv[3]; }
        const float val = (a0 + a1) + (a2 + a3);
        Tr[s] = (s < x31) ? val : Tr[s];
    }
#pragma unroll
    for (int c8 = 0; c8 < 4; ++c8) { float f[8];
#pragma unroll
        for (int e = 0; e < 8; ++e) f[e] = Tr[8 * c8 + e];
        *(LAS v4u*)(dst + c8 * 16) = pack8(f); }
}
__device__ __forceinline__ void rwkv_chunk_unit(Frame& F, int unit) {
    LAS unsigned char* L = F.lds; const int tid = F.tid, lane = F.lane, wave = F.wave, x31 = lane & 31, h = lane >> 5;
    const int bh = unit >> 7, c = unit & 127, b = bh >> 4, hd = bh & 15;
    const bf16* SB = (const bf16*)(F.ws + WS_SB); const bf16* XL = (const bf16*)(F.ws + WS_XL);
    {
        const int tok = tid >> 3, cg = tid & 7, ch0 = hd * 64 + 8 * cg; const size_t m = (size_t)b * SEQ + c * 64 + tok;
        RwElem E; rwkv_elem(F, SB, XL, m, (c * 64 + tok) == 0, ch0, E);
        LAS float* CL = (LAS float*)(L + RW_CL); LAS float* TOT = (LAS float*)(L + RW_TOT);
        *(LAS f32x4*)(CL + tok * 64 + 8 * cg) = (f32x4){E.lw[0], E.lw[1], E.lw[2], E.lw[3]}; *(LAS f32x4*)(CL + tok * 64 + 8 * cg + 4) = (f32x4){E.lw[4], E.lw[5], E.lw[6], E.lw[7]};
        __syncthreads();
        { const int j = tid & 63, tg = tid >> 6; float p[8], run = 0.f;
#pragma unroll
          for (int e = 0; e < 8; ++e) { run += CL[(8 * tg + e) * 64 + j]; p[e] = run; }
          TOT[tg * 64 + j] = run;
          __syncthreads();
          float off = 0.f;
#pragma unroll
          for (int g = 0; g < 7; ++g) off += (g < tg) ? TOT[g * 64 + j] : 0.f;
#pragma unroll
          for (int e = 0; e < 8; ++e) CL[(8 * tg + e) * 64 + j] = p[e] + off; }
        __syncthreads();
        const f32x4 c0 = *(const LAS f32x4*)(CL + tok * 64 + 8 * cg), c1 = *(const LAS f32x4*)(CL + tok * 64 + 8 * cg + 4);
        float fa[8], fr[8], fb[8], fk[8];
#pragma unroll
        for (int e = 0; e < 8; ++e) { const float cl = e < 4 ? c0[e] : c1[e - 4]; const float ep = __expf(cl), en = __expf(-cl), ea = __expf(cl - E.lw[e]);
            fa[e] = -E.kn[e] * ea; fr[e] = E.r[e] * ep; fb[e] = E.kn[e] * E.as[e] * en; fk[e] = E.kp[e] * en;
            if (tok == 63) ((LAS float*)(L + RW_GC))[8 * cg + e] = ep; }
        const int o = tok * RW_PB + cg * 16;
        *(LAS v4u*)(L + RW_TA + o) = pack8(fa); *(LAS v4u*)(L + RW_TR + o) = pack8(fr); *(LAS v4u*)(L + RW_TB + o) = pack8(fb); *(LAS v4u*)(L + RW_TK + o) = pack8(fk); *(LAS v4u*)(L + RW_TV + o) = pack8(E.v);
    }
    __syncthreads();
    for (int ti = wave; ti < 12; ti += 8) {
        const int prod = ti / 3, tt = ti % 3, sh = tt == 2 ? 1 : 0, th = tt == 0 ? 0 : 1;
        const LAS unsigned char* Bm = L + ((prod & 1) ? RW_TK : RW_TB); const LAS unsigned char* Am = L + ((prod & 2) ? RW_TR : RW_TA);
        f32x16 acc = {};
#pragma unroll
        for (int ks = 0; ks < 4; ++ks) acc = RW_MFMA(rw_row(Bm, RW_PB, 32 * sh, 16 * ks, lane), rw_row(Am, RW_PB, 32 * th, 16 * ks, lane), acc);
        if (sh == th) {
            const bool strict = prod < 2;
#pragma unroll
            for (int i = 0; i < 16; ++i) { const int s = crow(i, h); if (strict ? (s >= x31) : (s > x31)) acc[i] = 0.f; }
        }
        if (prod == 0) {
            if (sh == th) { LAS float* LF = (LAS float*)(L + RW_LABF) + sh * 1024;
#pragma unroll
                for (int i = 0; i < 16; ++i) LF[crow(i, h) * 32 + x31] = acc[i]; }
            else rw_st_lr(L + RW_L21, RW_PS, x31, 0, acc, h);
        } else rw_st_lr(L + (prod == 1 ? RW_LAK : prod == 2 ? RW_MRB : RW_MRK), RW_PB, 32 * th + x31, 32 * sh, acc, h);
    }
    __syncthreads();
    f32x16 keepQ = {}, keepY = {};
    if (wave == 0) {
        rw_inv32((const LAS float*)(L + RW_LABF) + h * 1024, L + RW_TT + (32 * h + x31) * RW_PS, x31);
    } else if (wave < 4) {
        for (int ti = wave - 1; ti < 4; ti += 3) { const int th = ti >> 1, ih = ti & 1;
            f32x16 acc = {};
            for (int ks = 0; ks < 2 * (th + 1); ++ks) acc = RW_MFMA(rw_row(L + RW_LAK, RW_PB, 32 * th, 16 * ks, lane), rw_tr(L + RW_TV, RW_PB, 16 * ks, 32 * ih, lane), acc);
            rw_st_lr(L + RW_R2T, RW_PB, 32 * ih + x31, 32 * th, acc, h); }
    } else {
        const int w4 = wave - 4, hi2 = w4 >> 1, lo2 = w4 & 1;
#pragma unroll
        for (int ks = 0; ks < 4; ++ks) keepQ = RW_MFMA(rw_tr(L + RW_TK, RW_PB, 16 * ks, 32 * hi2, lane), rw_tr(L + RW_TV, RW_PB, 16 * ks, 32 * lo2, lane), keepQ);
        for (int ks = 0; ks < 2 * (lo2 + 1); ++ks) keepY = RW_MFMA(rw_tr(L + RW_TV, RW_PB, 16 * ks, 32 * hi2, lane), rw_row(L + RW_MRK, RW_PB, 32 * lo2, 16 * ks, lane), keepY);
    }
    __syncthreads();
    if (wave < 4) { const int nh = wave;
        f32x16 acc = {};
#pragma unroll
        for (int ks = 0; ks < 2; ++ks) { const bf16x8 af = rw_row(L + RW_TT, RW_PS, 0, 16 * ks, lane);
            const bf16x8 bfr = nh < 2 ? rw_tr(L + RW_TA, RW_PB, 16 * ks, 32 * nh, lane) : rw_row(L + RW_R2T, RW_PB, 32 * (nh - 2), 16 * ks, lane);
            acc = RW_MFMA(af, bfr, acc); }
        rw_st_lr(L + RW_XT, RW_PB, 32 * nh + x31, 0, acc, h);
    }
    __syncthreads();
    if (wave < 4) { const int nh = wave;
        f32x16 z = {};
#pragma unroll
        for (int ks = 0; ks < 2; ++ks) z = RW_MFMA(rw_row(L + RW_L21, RW_PS, 0, 16 * ks, lane), rw_row(L + RW_XT, RW_PB, 32 * nh, 16 * ks, lane), z);
        f32x16 acc = {};
#pragma unroll
        for (int ks = 0; ks < 2; ++ks) { const bf16x8 af = rw_row(L + RW_TT, RW_PS, 32, 16 * ks, lane);
            const bf16x8 bfr = nh < 2 ? rw_tr(L + RW_TA, RW_PB, 32 + 16 * ks, 32 * nh, lane) : rw_row(L + RW_R2T, RW_PB, 32 * (nh - 2), 32 + 16 * ks, lane);
            acc = RW_MFMA(af, bfr, acc); }
#pragma unroll
        for (int ks = 0; ks < 2; ++ks) {
            const LAS unsigned char* tp = L + RW_TT + (32 + x31) * RW_PS + (16 * ks + 4 * h) * 2;
            const u32x2 t0 = *(const LAS u32x2*)tp, t1 = *(const LAS u32x2*)(tp + 16);
            const v4u aw = {t0.x, t0.y, t1.x, t1.y};
            v4u zw; zw.x = pk2(z[8 * ks + 0], z[8 * ks + 1]); zw.y = pk2(z[8 * ks + 2], z[8 * ks + 3]); zw.z = pk2(z[8 * ks + 4], z[8 * ks + 5]); zw.w = pk2(z[8 * ks + 6], z[8 * ks + 7]);
            acc = RW_MFMA(__builtin_bit_cast(bf16x8, aw), __builtin_bit_cast(bf16x8, zw), acc); }
        rw_st_lr(L + RW_XT, RW_PB, 32 * nh + x31, 32, acc, h);
    }
    __syncthreads();
    const LAS float* GC = (const LAS float*)(L + RW_GC);
    if (wave < 4) {
        { const int j2h = wave >> 1, jh = wave & 1;
          f32x16 acc = {};
#pragma unroll
          for (int ks = 0; ks < 4; ++ks) acc = RW_MFMA(rw_row(L + RW_XT, RW_PB, 32 * j2h, 16 * ks, lane), rw_tr(L + RW_TB, RW_PB, 16 * ks, 32 * jh, lane), acc);
          const float g = GC[32 * jh + x31];
          bf16* Pg = (bf16*)(F.ws + WS_PB) + (size_t)unit * 4096 + (size_t)(32 * jh + x31) * 64 + 32 * j2h;
#pragma unroll
          for (int q = 0; q < 4; ++q) { float v[4];
#pragma unroll
              for (int e = 0; e < 4; ++e) { const int j2 = 32 * j2h + 8 * q + 4 * h + e; v[e] = g * (acc[4 * q + e] + ((j2 == 32 * jh + x31) ? 1.f : 0.f)); }
              const int off = 8 * q + 4 * h, pos = 8 * ((off & 15) >> 2) + 4 * (off >> 4);
              u32x2 w; w.x = pk2(v[0], v[1]); w.y = pk2(v[2], v[3]); *(GAS u32x2*)(Pg + pos) = w; } }
        { const int jh = wave >> 1, th = wave & 1;
          f32x16 acc = {};
          for (int ks = 0; ks < 2 * (th + 1); ++ks) acc = RW_MFMA(rw_row(L + RW_XT, RW_PB, 32 * jh, 16 * ks, lane), rw_row(L + RW_MRB, RW_PB, 32 * th, 16 * ks, lane), acc);
#pragma unroll
          for (int q = 0; q < 4; ++q) { const u32x2 rr = *(const LAS u32x2*)(L + RW_TR + (32 * th + x31) * RW_PB + (32 * jh + 8 * q + 4 * h) * 2);
              acc[4 * q] += bflo(rr.x); acc[4 * q + 1] += bfhi(rr.x); acc[4 * q + 2] += bflo(rr.y); acc[4 * q + 3] += bfhi(rr.y); }
          rw_st_lr_g((bf16*)(F.ws + WS_GB) + (size_t)unit * 4096, 64, 32 * th + x31, 32 * jh, acc, h); }
    } else {
        const int w4 = wave - 4, hi2 = w4 >> 1, lo2 = w4 & 1;
        {
#pragma unroll
          for (int ks = 0; ks < 4; ++ks) keepQ = RW_MFMA(rw_tr(L + RW_TB, RW_PB, 16 * ks, 32 * hi2, lane), rw_row(L + RW_XT, RW_PB, 64 + 32 * lo2, 16 * ks, lane), keepQ);
#pragma unroll
          for (int i = 0; i < 16; ++i) keepQ[i] *= GC[32 * hi2 + crow(i, h)];
          rw_st_lr_g((bf16*)(F.ws + WS_QB) + (size_t)unit * 4096, 64, 32 * lo2 + x31, 32 * hi2, keepQ, h); }
        {
          for (int ks = 0; ks < 2 * (lo2 + 1); ++ks) keepY = RW_MFMA(rw_row(L + RW_XT, RW_PB, 64 + 32 * hi2, 16 * ks, lane), rw_row(L + RW_MRB, RW_PB, 32 * lo2, 16 * ks, lane), keepY);
          rw_st_lr_g((bf16*)(F.ws + WS_YB) + (size_t)unit * 4096, 64, 32 * lo2 + x31, 32 * hi2, keepY, h); }
    }
    __syncthreads();
}
__device__ __forceinline__ void rwkv_chunk_phase(Frame& F) {
    for (int u = F.vcu; u < BATCH * NH * 128; u += F.G) rwkv_chunk_unit(F, u);
}

typedef float f32x4_t __attribute__((ext_vector_type(4)));
__device__ __forceinline__ void rwkv_scan_phase(Frame& F) {
    if (F.vcu >= BATCH * NH * 4 || F.wave != 0) return;
    const int bh = F.vcu >> 2, isl = F.vcu & 3, lane = F.lane, i16 = lane & 15, jg = lane >> 4;
    const bf16* PBf = (const bf16*)(F.ws + WS_PB) + (size_t)bh * 128 * 4096;
    const bf16* QBf = (const bf16*)(F.ws + WS_QB) + (size_t)bh * 128 * 4096 + (size_t)(16 * isl + i16) * 64 + 4 * jg;
    bf16* HBf = (bf16*)(F.ws + WS_HB) + (size_t)bh * 128 * 4096 + (size_t)(16 * isl + i16) * 64 + 4 * jg;
    f32x4_t hacc[4];
#pragma unroll
    for (int mt = 0; mt < 4; ++mt) hacc[mt] = (f32x4_t){0.f, 0.f, 0.f, 0.f};
    v4u pf[4][2]; u32x2 qf[4];
#pragma unroll
    for (int mt = 0; mt < 4; ++mt) { qf[mt] = *(const GAS u32x2*)(QBf + 16 * mt);
#pragma unroll
        for (int st = 0; st < 2; ++st) pf[mt][st] = *(const GAS v4u*)(PBf + (size_t)(16 * mt + i16) * 64 + 32 * st + 8 * jg); }
    for (int c = 0; c < 128; ++c) {
        v4u hb[2];
#pragma unroll
        for (int mt = 0; mt < 4; ++mt) { u32x2 w; w.x = pk2(hacc[mt][0], hacc[mt][1]); w.y = pk2(hacc[mt][2], hacc[mt][3]);
            *(GAS u32x2*)(HBf + (size_t)c * 4096 + 16 * mt) = w;
            if (mt & 1) { hb[mt >> 1].z = w.x; hb[mt >> 1].w = w.y; } else { hb[mt >> 1].x = w.x; hb[mt >> 1].y = w.y; } }
        v4u pc[4][2]; u32x2 qc[4];
#pragma unroll
        for (int mt = 0; mt < 4; ++mt) { qc[mt] = qf[mt]; pc[mt][0] = pf[mt][0]; pc[mt][1] = pf[mt][1]; }
        if (c + 1 < 128) {
#pragma unroll
            for (int mt = 0; mt < 4; ++mt) { qf[mt] = *(const GAS u32x2*)(QBf + (size_t)(c + 1) * 4096 + 16 * mt);
#pragma unroll
                for (int st = 0; st < 2; ++st) pf[mt][st] = *(const GAS v4u*)(PBf + (size_t)(c + 1) * 4096 + (size_t)(16 * mt + i16) * 64 + 32 * st + 8 * jg); }
        }
#pragma unroll
        for (int mt = 0; mt < 4; ++mt) {
            f32x4_t a = {bflo(qc[mt].x), bfhi(qc[mt].x), bflo(qc[mt].y), bfhi(qc[mt].y)};
#pragma unroll
            for (int st = 0; st < 2; ++st) a = __builtin_amdgcn_mfma_f32_16x16x32_bf16(__builtin_bit_cast(bf16x8, pc[mt][st]), __builtin_bit_cast(bf16x8, hb[st]), a, 0, 0, 0);
            hacc[mt] = a;
        }
    }
}

constexpr int RWC_WLDS = 32 * 272;
__device__ __forceinline__ void rwkv_out_phase(Frame& F) {
    const int lane = F.lane, x31 = lane & 31, h = lane >> 5;
    LAS unsigned char* wl = F.lds + F.wave * RWC_WLDS;
    const bf16* SB = (const bf16*)(F.ws + WS_SB); const bf16* SC = (const bf16*)(F.ws + WS_SC); const bf16* XL = (const bf16*)(F.ws + WS_XL); bf16* MIX = (bf16*)(F.ws + WS_MIX);
    const int gw = F.vcu * NWAVES + F.wave, NGW = F.G * NWAVES;
    for (int it = gw; it < BATCH * NH * 128 * 2; it += NGW) {
        const int unit = it >> 1, th = it & 1, bh = unit >> 7, c = unit & 127, b = bh >> 4, hd = bh & 15;
        const bf16* Hg = (const bf16*)(F.ws + WS_HB) + (size_t)unit * 4096; const bf16* Gg = (const bf16*)(F.ws + WS_GB) + (size_t)unit * 4096; const bf16* Yg = (const bf16*)(F.ws + WS_YB) + (size_t)unit * 4096;
        f32x16 y[2];
#pragma unroll
        for (int ih = 0; ih < 2; ++ih) {
#pragma unroll
            for (int q = 0; q < 4; ++q) { const u32x2 w = *(const GAS u32x2*)(Yg + (size_t)(32 * th + x31) * 64 + 32 * ih + 8 * q + 4 * h);
                y[ih][4 * q] = bflo(w.x); y[ih][4 * q + 1] = bfhi(w.x); y[ih][4 * q + 2] = bflo(w.y); y[ih][4 * q + 3] = bfhi(w.y); }
#pragma unroll
            for (int ks = 0; ks < 4; ++ks) { const bf16x8 af = *(const GAS bf16x8*)(Hg + (size_t)(32 * ih + x31) * 64 + 16 * ks + 8 * h), bfr = *(const GAS bf16x8*)(Gg + (size_t)(32 * th + x31) * 64 + 16 * ks + 8 * h);
                y[ih] = RW_MFMA(af, bfr, y[ih]); }
        }
        float s = 0.f;
#pragma unroll
        for (int ih = 0; ih < 2; ++ih)
#pragma unroll
            for (int i = 0; i < 16; ++i) s += y[ih][i];
        s += __shfl_xor(s, 32); const float mean = s * (1.0f / 64.0f); float q2 = 0.f;
#pragma unroll
        for (int ih = 0; ih < 2; ++ih)
#pragma unroll
            for (int i = 0; i < 16; ++i) { y[ih][i] -= mean; q2 += y[ih][i] * y[ih][i]; }
        q2 += __shfl_xor(q2, 32); const float rstd = 1.0f / sqrtf(q2 * (1.0f / 64.0f) + LNX_EPS);
#pragma unroll
        for (int ih = 0; ih < 2; ++ih)
#pragma unroll
            for (int q = 0; q < 4; ++q) *(LAS f32x4*)(wl + x31 * 272 + (32 * ih + 8 * q + 4 * h) * 4) = (f32x4){y[ih][4 * q] * rstd, y[ih][4 * q + 1] * rstd, y[ih][4 * q + 2] * rstd, y[ih][4 * q + 3] * rstd};
        LDS_WAIT(); asm volatile("" ::: "memory");
#pragma unroll 1
        for (int ps = 0; ps < 4; ++ps) { const int tok = 8 * ps + (lane >> 3), cg = lane & 7, ch0 = hd * 64 + 8 * cg; const size_t m = (size_t)b * SEQ + c * 64 + 32 * th + tok;
            RwElem E; rwkv_elem(F, SB, XL, m, (c * 64 + 32 * th + tok) == 0, ch0, E);
            float bon = 0.f, g[8], z[8], f[8];
#pragma unroll
            for (int e = 0; e < 8; ++e) bon += E.r[e] * E.kp[e] * F.r_k[ch0 + e];
            bon = red8(bon);
            unpack8(*(const GAS v4u*)(XL + m * 3072 + 2048 + ch0), g); unpack8(*(const GAS v4u*)(SC + m * 1024 + ch0), z);
            const f32x4 y0 = *(const LAS f32x4*)(wl + tok * 272 + cg * 32), y1 = *(const LAS f32x4*)(wl + tok * 272 + cg * 32 + 16);
#pragma unroll
            for (int e = 0; e < 8; ++e) { const float yn = e < 4 ? y0[e] : y1[e - 4]; f[e] = (yn * F.lnx_g[ch0 + e] + F.lnx_b[ch0 + e] + bon * E.v[e]) * g[e] * z[e]; }
            *(GAS v4u*)(MIX + m * 2048 + 1024 + ch0) = pack8(f); }
        LDS_WAIT(); asm volatile("" ::: "memory");
    }
}
struct Args { const float* in[16]; float* out; unsigned char* ws; int ph_lo, ph_hi, li, pad; };
__global__ void __launch_bounds__(NWAVES * 64, 2) hymba_fwd(Args args) {
    extern __shared__ __attribute__((aligned(16))) unsigned char lds[];
    Frame F;
    F.lds = (LAS unsigned char*)lds;
    F.tid = threadIdx.x; F.lane = F.tid & 63; F.wave = __builtin_amdgcn_readfirstlane(F.tid >> 6);
    F.G = gridDim.x; { const int bx = blockIdx.x; F.vcu = (F.G % 8 == 0) ? (bx % 8) * (F.G / 8) + bx / 8 : bx; }
    F.x = args.in[0]; F.norm_g = args.in[1]; F.w_in = args.in[2]; F.shift_mu = args.in[3]; F.w0 = args.in[4]; F.w2 = args.in[5]; F.a0 = args.in[6]; F.a2 = args.in[7]; F.g2 = args.in[8];
    F.k_k = args.in[9]; F.k_a = args.in[10]; F.r_k = args.in[11]; F.lnx_g = args.in[12]; F.lnx_b = args.in[13]; F.w_out = args.in[14]; F.final_g = args.in[15];
    F.out = args.out; F.ws = args.ws;
    volatile LAS unsigned* MISC = (volatile LAS unsigned*)(F.lds + MISC_OFF);
    for (int u = F.tid; u < (LDS_BYTES - LDSCTL_OFF) / 4; u += NWAVES * 64) ((LAS unsigned*)(F.lds + LDSCTL_OFF))[u] = 0u;
    __syncthreads();
    gu32* ctl = (gu32*)(F.ws + WS_CTL);
    XcdBarrier bar; bar.bar = (unsigned*)(ctl + CW_BAR); bar.x = 0; bar.st = nullptr;
    if (N_LAUNCHES != NPHASE) bar = xcd_barrier_post((unsigned*)(ctl + CW_BAR) + args.li * XCD_BAR_WORDS, MISC + 8);
    const int lo = args.ph_lo, hi = args.ph_hi;
#ifndef PHMASK
#define PHMASK 0x3ff
#endif
#ifndef RWKV_SEQ
#define RWKV_SEQ 0
#endif
#ifndef PROBE_MASK
#define PROBE_MASK 0
#endif
#define IN(k) (((pmask >> (k)) & 1u) && lo <= (k) && (k) < hi)
#define SEAM(k) do { if (lo <= (k) && (k) + 1 < hi) xcd_barrier(bar); } while (0)
#define PHASE_PROGRAM() \
    if (IN(0)) { p0_prologue(F); } SEAM(0); \
    if (IN(1)) { \
        pg8::Gemm g{(const pg8::bf16_t*)(F.ws + WS_XN), (const pg8::bf16_t*)(F.ws + WS_BT1), M, N1, DM + args.pad}; pg8::StaticOrder S; S.init(M, N1, F.G, (int)blockIdx.x); \
        EpiProj E{(pg8::bf16_t*)(F.ws + WS_SA), (pg8::bf16_t*)(F.ws + WS_SB), (pg8::bf16_t*)(F.ws + WS_SC), (pg8::bf16_t*)(F.ws + WS_SD), (const float*)(F.ws + WS_COS), (const float*)(F.ws + WS_SIN)}; \
        pg8::gemm_phase<EpiProj, pg8::StaticOrder, true, true>(F.lds, g, S, E); \
    } SEAM(1); \
    if (IN(2)) { attn_phase(F); lora_act_phase(F); } SEAM(2); \
    if (IN(3)) { combine_phase(F); } SEAM(3); \
    if (IN(4)) { \
        pg8::Gemm g{(const pg8::bf16_t*)(F.ws + WS_AL), (const pg8::bf16_t*)(F.ws + WS_BTL), M, NLORA, KLORA + args.pad}; pg8::StaticOrder S; S.init(M, NLORA, F.G, (int)blockIdx.x); \
        pg8::EpiBf16<0> E{(pg8::bf16_t*)(F.ws + WS_XL), NLORA, nullptr, 0, 0, 1.f}; \
        pg8::gemm_phase<pg8::EpiBf16<0>, pg8::StaticOrder, true, true>(F.lds, g, S, E); \
    } SEAM(4); \
    if (IN(5)) { if (RWKV_SEQ) rwkv_seq_phase(F); else rwkv_chunk_phase(F); } SEAM(5); \
    if (IN(6)) { if (!RWKV_SEQ) rwkv_scan_phase(F); } SEAM(6); \
    if (IN(7)) { if (!RWKV_SEQ) rwkv_out_phase(F); } SEAM(7); \
    if (IN(8)) { \
        pg8::Gemm g{(const pg8::bf16_t*)(F.ws + WS_MIX), (const pg8::bf16_t*)(F.ws + WS_BT2), M, DM, DM + args.pad}; pg8::StaticOrder S; S.init(M, DM, F.G, (int)blockIdx.x); \
        EpiOut E{F.x, F.out, (float*)(F.ws + WS_SSQ)}; \
        pg8::gemm_phase<EpiOut, pg8::StaticOrder, true, true>(F.lds, g, S, E); \
    } SEAM(8); \
    if (IN(9)) { final_norm_phase(F); }
    if (PROBE_MASK) { const unsigned pmask = (unsigned)(PROBE_MASK); PHASE_PROGRAM() xcd_barrier(bar); }
    { const unsigned pmask = (unsigned)(PHMASK); PHASE_PROGRAM() }
#undef PHASE_PROGRAM
#undef IN
#undef SEAM
}

extern "C" void kernel_launch(void* const* d_in, const int* in_sizes, int n_in, void* d_out, int out_size, void* d_ws, size_t ws_size, hipStream_t stream) {
    static int grid = 0;
    if (grid == 0) {
        if (n_in != 16 || in_sizes[0] != M * DM || out_size != M * DM || ws_size < WS_END) { fprintf(stderr, "kernel_launch: unexpected shapes (n_in %d, in0 %d, out %d, ws %zu)\n", n_in, n_in > 0 ? in_sizes[0] : -1, out_size, ws_size); grid = -1; return; }
        int dev = 0, cus = 0, per_cu = 0;
        if (hipGetDevice(&dev) != hipSuccess || hipDeviceGetAttribute(&cus, hipDeviceAttributeMultiprocessorCount, dev) != hipSuccess) { grid = -1; return; }
        if (hipFuncSetAttribute((const void*)hymba_fwd, hipFuncAttributeMaxDynamicSharedMemorySize, LDS_BYTES) != hipSuccess) { grid = -1; return; }
        if (hipOccupancyMaxActiveBlocksPerMultiprocessor(&per_cu, (const void*)hymba_fwd, NWAVES * 64, LDS_BYTES) != hipSuccess || per_cu < 1) { fprintf(stderr, "kernel_launch: occupancy query says %d blocks per CU\n", per_cu); grid = -1; return; }
        (void)hipGetLastError();
        grid = cus;
    }
    if (grid < 0) return;
    if (hipMemsetAsync((char*)d_ws + WS_CTL, 0, CTL_ZERO_BYTES, stream) != hipSuccess) return;
    Args a{};
    for (int i = 0; i < 16; ++i) a.in[i] = (const float*)d_in[i];
    a.out = (float*)d_out; a.ws = (unsigned char*)d_ws;
    if (N_LAUNCHES == 1) { a.ph_lo = 0; a.ph_hi = NPHASE; a.li = 0; hipLaunchKernelGGL(hymba_fwd, dim3(grid), dim3(NWAVES * 64), LDS_BYTES, stream, a); }
    else for (int li = 0; li < NPHASE; ++li) { a.ph_lo = li; a.ph_hi = li + 1; a.li = 0; hipLaunchKernelGGL(hymba_fwd, dim3(grid), dim3(NWAVES * 64), LDS_BYTES, stream, a); }
}
```

```cpp
#include <hip/hip_runtime.h>
#include <cstdio>
#include <cstdint>
namespace pg8 {
#define PG8_LAS __attribute__((address_space(3)))
typedef unsigned short bf16_t;
typedef short bf16x8 __attribute__((ext_vector_type(8)));
typedef float f32x4 __attribute__((ext_vector_type(4)));
typedef unsigned u32x4 __attribute__((ext_vector_type(4)));
constexpr int BM = 256, BK = 64, HALF = 128, HTB = HALF * BK * 2  , STAGE_BYTES = 8 * HTB, NXCD = 8, WGM = 8;

__host__ __device__ __forceinline__ int lds_byte(int r, int c) { const int st = (r >> 4) * 2 + (c >> 5), rr = r & 15, cc = c & 31, ob = rr * 64 + cc * 2; return st * 1024 + (ob ^ (((ob >> 9) & 1) << 5)); }
__host__ __device__ __forceinline__ void stage_rc(int b, int& R, int& C) { const int st = b / 1024, sb = b % 1024, swz = sb ^ (((sb >> 9) & 1) << 5); R = (st >> 1) * 16 + swz / 64; C = (st & 1) * 32 + (swz % 64) / 2; }
__host__ __device__ __forceinline__ int perm32(int rho) { const int n = rho >> 4, i = rho & 15; return 8 * (i >> 2) + 4 * n + (i & 3); }

struct Unit { int pm, pn; };
struct Gemm { const bf16_t* A; const bf16_t* Bt; int M, N, K; };

struct StaticOrder {
    int nM, nN, nwg, G, c;
    __host__ __device__ void init(int M, int N, int G_, int c_) { nM = M / BM; nN = N / BM; nwg = nM * nN; G = G_; c = c_; }
    __host__ __device__ bool next(int i, Unit& u) const {
        const long L = (long)i * G + c; if (L >= nwg) return false;
        int wgid = (int)L; { const int q = nwg / NXCD, r = nwg % NXCD, xcd = wgid % NXCD, off = wgid / NXCD; wgid = (xcd < r ? xcd * (q + 1) : r * (q + 1) + (xcd - r) * q) + off; }
        const int nig = WGM * nN, gid = wgid / nig, fm = gid * WGM, gsz = (nM - fm) < WGM ? (nM - fm) : WGM;
        u.pm = fm + ((wgid % nig) % gsz); u.pn = (wgid % nig) / gsz; return true;
    }
    __device__ __forceinline__ void a_ready(const Unit&) const {}
    __device__ __forceinline__ void done(const Unit&) const {}
};

__device__ __forceinline__ unsigned cvt_pk_bf16(float lo, float hi) { unsigned r; asm volatile("v_cvt_pk_bf16_f32 %0, %1, %2" : "=v"(r) : "v"(lo), "v"(hi)); return r; }
typedef float f32x2 __attribute__((ext_vector_type(2)));
__device__ __forceinline__ f32x2 gelu_pk(f32x2 v) {
    const f32x2 av = __builtin_elementwise_abs(v), d = av * 0.2316418882f + 1.0f;
    f32x2 t; t.x = __builtin_amdgcn_rcpf(d.x); t.y = __builtin_amdgcn_rcpf(d.y);
    f32x2 q = t * 0.5307027145f + (-0.7265760135f); q = q * t + 0.7107068705f; q = q * t + (-0.142248368f); q = q * t + 0.127414796f; q = q * t;
    const f32x2 s = (v * v) * (-0.72134752044f);
    f32x2 e; e.x = __builtin_amdgcn_exp2f(s.x); e.y = __builtin_amdgcn_exp2f(s.y);
    const f32x2 m = v * (q * e), r = v - m;
    f32x2 o; o.x = v.x < 0.f ? m.x : r.x; o.y = v.y < 0.f ? m.y : r.y; return o;
}

template <int ACT  > struct EpiBf16 {
    static constexpr bool PERM = true, AFTER_DRAIN = false; static_assert(ACT == 0 || ACT == 1, "EpiBf16: ACT is 0 (none) or 1 (gelu_pk)");
    bf16_t* O; int ldc; const float* bias; int split_cols; size_t split_stride; float scale0;
    __device__ __forceinline__ void operator()(const f32x4 (&acc)[2][2][4][2], const Unit& u, int wr, int wc, int fr, int fq) const {
        const int row0 = u.pm * BM + wr * 64 + fr; int colt = u.pn * BM; bf16_t* base = O;
        float sc = 1.f; if (split_cols) { const int t = colt / split_cols; base += (size_t)t * split_stride; colt -= t * split_cols; if (t == 0) sc = scale0; }
        const int col0 = colt + wc * 32 + 8 * fq, bcol0 = u.pn * BM + wc * 32 + 8 * fq;
        f32x4 bv[2][2];
#pragma unroll
        for (int bj = 0; bj < 2; ++bj)
#pragma unroll
            for (int n = 0; n < 2; ++n) bv[bj][n] = bias ? *(const f32x4*)(bias + bcol0 + bj * HALF + 4 * n) : (f32x4){0.f, 0.f, 0.f, 0.f};
#pragma unroll
        for (int ai = 0; ai < 2; ++ai)
#pragma unroll
            for (int m = 0; m < 4; ++m) { bf16_t* rowp = base + (size_t)(row0 + ai * HALF + m * 16) * ldc + col0;
#pragma unroll
                for (int bj = 0; bj < 2; ++bj) { f32x4 v0 = acc[ai][bj][m][0] + bv[bj][0], v1 = acc[ai][bj][m][1] + bv[bj][1];
                    if (ACT == 1) { f32x2 a = gelu_pk((f32x2){v0[0], v0[1]}), b = gelu_pk((f32x2){v0[2], v0[3]}), c = gelu_pk((f32x2){v1[0], v1[1]}), d = gelu_pk((f32x2){v1[2], v1[3]});
                        v0 = (f32x4){a.x, a.y, b.x, b.y}; v1 = (f32x4){c.x, c.y, d.x, d.y}; }
                    v0 = v0 * sc; v1 = v1 * sc; u32x4 w; w.x = cvt_pk_bf16(v0[0], v0[1]); w.y = cvt_pk_bf16(v0[2], v0[3]); w.z = cvt_pk_bf16(v1[0], v1[1]); w.w = cvt_pk_bf16(v1[2], v1[3]);
                    *(u32x4*)(rowp + bj * HALF) = w; } }
    }
};


template <class Epi, class Sched, bool ALIGN_EPI = false, bool SP2 = false>
__device__ __forceinline__ void gemm_phase(PG8_LAS unsigned char* lds, const Gemm g, const Sched& S, const Epi& E) {
    const int tid = threadIdx.x, wid = __builtin_amdgcn_readfirstlane(tid >> 6), lane = tid & 63, wr = wid >> 2, wc = wid & 3, fr = lane & 15, fq = lane >> 4;
    const int K = g.K, nt = K / BK;
    unsigned voffA[2], voffB[2];
#pragma unroll
    for (int i = 0; i < 2; ++i) { int R, C; stage_rc(tid * 16 + i * 8192, R, C); const int Rb = Epi::PERM ? ((R & ~31) + perm32(R & 31)) : R;
        voffA[i] = (unsigned)(R * K + C) * 2u; voffB[i] = (unsigned)(Rb * K + C) * 2u; }
    const size_t kstep = (size_t)(BK * 2);
    const size_t hstep = (size_t)HALF * K * 2;
    const size_t tstep = 2 * hstep;
    const unsigned ldsw = (unsigned)wid * 1024u;
    const int aoff = lds_byte(wr * 64 + fr, fq * 8), boff = lds_byte(wc * 32 + fr, fq * 8);
#define PG8_SA(b, h) (((b) * 2 + (h)) * HTB)
#define PG8_SB(b, h) ((4 + (b) * 2 + (h)) * HTB)
#define PG8_STAGE(bufoff, gbase, voff) do { _Pragma("unroll") for (int _i = 0; _i < 2; ++_i) \
        __builtin_amdgcn_global_load_lds((const unsigned*)((const char*)(gbase) + (voff)[_i]), (PG8_LAS unsigned*)(lds + (bufoff) + ldsw + _i * 8192), 16, 0, 0); } while (0)
#define PG8_LDA(dst, b, h) do { _Pragma("unroll") for (int m = 0; m < 4; ++m) _Pragma("unroll") for (int k = 0; k < 2; ++k) dst[m][k] = *(const PG8_LAS bf16x8*)(lds + PG8_SA(b, h) + aoff + m * 2048 + k * 1024); } while (0)
#define PG8_LDB(dst, b, h) do { _Pragma("unroll") for (int n = 0; n < 2; ++n) _Pragma("unroll") for (int k = 0; k < 2; ++k) dst[n][k] = *(const PG8_LAS bf16x8*)(lds + PG8_SB(b, h) + boff + n * 2048 + k * 1024); } while (0)
#define PG8_MMA(ai, bj, At, Bt) do { __builtin_amdgcn_s_setprio(1); _Pragma("unroll") for (int m = 0; m < 4; ++m) _Pragma("unroll") for (int n = 0; n < 2; ++n) _Pragma("unroll") for (int k = 0; k < 2; ++k) \
        acc[ai][bj][m][n] = __builtin_amdgcn_mfma_f32_16x16x32_bf16(Bt[n][k], At[m][k], acc[ai][bj][m][n], 0, 0, 0); __builtin_amdgcn_s_setprio(0); } while (0)
#define PG8_WAIT_V(n) asm volatile("s_waitcnt vmcnt(" #n ")" ::: "memory")
#define PG8_WAIT_L(n) asm volatile("s_waitcnt lgkmcnt(" #n ")" ::: "memory")
#define PG8_BAR __builtin_amdgcn_s_barrier()
#define PG8_SCHED __builtin_amdgcn_sched_barrier(0)
    Unit cur, nxt; int ui = 0;
    if (!S.next(0, cur)) return;
    f32x4 acc[2][2][4][2];
#pragma unroll
    for (int a = 0; a < 2; ++a)
#pragma unroll
        for (int b = 0; b < 2; ++b)
#pragma unroll
            for (int m = 0; m < 4; ++m)
#pragma unroll
                for (int n = 0; n < 2; ++n) acc[a][b][m][n] = (f32x4){0.f, 0.f, 0.f, 0.f};
    bf16x8 At[4][2], B0[2][2], B1[2][2];
    const char* cA = (const char*)g.A + (size_t)cur.pm * tstep; const char* cB = (const char*)g.Bt + (size_t)cur.pn * tstep;
    S.a_ready(cur);
    if constexpr (SP2) {
        PG8_STAGE(PG8_SB(0, 0), cB, voffB); PG8_STAGE(PG8_SB(0, 1), cB + hstep, voffB); PG8_STAGE(PG8_SA(0, 0), cA, voffA); PG8_STAGE(PG8_SA(0, 1), cA + hstep, voffA);
        if (wr == 1) PG8_BAR;
        PG8_WAIT_V(2); PG8_BAR;
        PG8_STAGE(PG8_SB(1, 0), cB + kstep, voffB); PG8_STAGE(PG8_SA(1, 0), cA + kstep, voffA); PG8_STAGE(PG8_SB(1, 1), cB + hstep + kstep, voffB);
        PG8_WAIT_V(6); PG8_BAR;
    } else {
        PG8_STAGE(PG8_SB(0, 0), cB, voffB); PG8_STAGE(PG8_SA(0, 0), cA, voffA); PG8_STAGE(PG8_SB(0, 1), cB + hstep, voffB); PG8_STAGE(PG8_SA(0, 1), cA + hstep, voffA);
        if (wr == 1) PG8_BAR;
        PG8_WAIT_V(4); PG8_BAR;
        PG8_STAGE(PG8_SB(1, 0), cB + kstep, voffB); PG8_STAGE(PG8_SA(1, 0), cA + kstep, voffA); PG8_STAGE(PG8_SB(1, 1), cB + hstep + kstep, voffB);
        PG8_WAIT_V(6); PG8_BAR;
    }
    for (;;) {
        const bool has_next = S.next(ui + 1, nxt);
        const char* nA = has_next ? (const char*)g.A + (size_t)nxt.pm * tstep : cA; const char* nB = has_next ? (const char*)g.Bt + (size_t)nxt.pn * tstep : cB;
        for (int t = 0; t < nt; t += 2) {
            const bool last = (t == nt - 2);
            const char* a1 = cA + (size_t)(t + 1) * kstep;
            const char* a2 = last ? nA : cA + (size_t)(t + 2) * kstep; const char* b2 = last ? nB : cB + (size_t)(t + 2) * kstep;
            const char* a3 = a2 + kstep; const char* b3 = b2 + kstep;
            if (last && has_next) S.a_ready(nxt);
            if constexpr (SP2) {
            PG8_LDB(B0, 0, 0); PG8_LDB(B1, 0, 1); PG8_SCHED; PG8_LDA(At, 0, 0); PG8_STAGE(PG8_SA(1, 1), a1 + hstep, voffA);
            PG8_WAIT_V(8); PG8_WAIT_L(0); PG8_BAR; PG8_MMA(0, 0, At, B0); PG8_MMA(0, 1, At, B1); PG8_BAR; PG8_SCHED;
            PG8_LDA(At, 0, 1); PG8_STAGE(PG8_SB(0, 0), b2, voffB); PG8_STAGE(PG8_SB(0, 1), b2 + hstep, voffB); PG8_STAGE(PG8_SA(0, 0), a2, voffA);
            PG8_WAIT_V(8); PG8_WAIT_L(0); PG8_BAR; PG8_MMA(1, 0, At, B0); PG8_MMA(1, 1, At, B1); PG8_BAR; PG8_SCHED;
            PG8_LDB(B0, 1, 0); PG8_LDB(B1, 1, 1); PG8_SCHED; PG8_LDA(At, 1, 0); PG8_STAGE(PG8_SA(0, 1), a2 + hstep, voffA);
            PG8_WAIT_V(8); PG8_WAIT_L(0); PG8_BAR; PG8_MMA(0, 0, At, B0); PG8_MMA(0, 1, At, B1); PG8_BAR; PG8_SCHED;
            PG8_LDA(At, 1, 1); PG8_STAGE(PG8_SB(1, 0), b3, voffB); PG8_STAGE(PG8_SB(1, 1), b3 + hstep, voffB); PG8_STAGE(PG8_SA(1, 0), a3, voffA);
            PG8_WAIT_V(8); PG8_WAIT_L(0); PG8_BAR; PG8_MMA(1, 0, At, B0); PG8_MMA(1, 1, At, B1); PG8_BAR; PG8_SCHED;
            } else {
            PG8_LDB(B0, 0, 0); PG8_SCHED; PG8_LDA(At, 0, 0); PG8_STAGE(PG8_SA(1, 1), a1 + hstep, voffA);
            PG8_WAIT_L(8); PG8_BAR; PG8_WAIT_L(0); PG8_MMA(0, 0, At, B0); PG8_BAR; PG8_SCHED;
            PG8_LDB(B1, 0, 1); PG8_STAGE(PG8_SB(0, 0), b2, voffB);
            PG8_BAR; PG8_WAIT_L(0); PG8_MMA(0, 1, At, B1); PG8_BAR;
            PG8_LDA(At, 0, 1); PG8_STAGE(PG8_SA(0, 0), a2, voffA);
            PG8_BAR; PG8_WAIT_L(0); PG8_MMA(1, 0, At, B0); PG8_BAR; PG8_SCHED;
            PG8_STAGE(PG8_SB(0, 1), b2 + hstep, voffB);
            PG8_WAIT_V(6); PG8_BAR; PG8_MMA(1, 1, At, B1); PG8_BAR;
            PG8_LDB(B0, 1, 0); PG8_SCHED; PG8_LDA(At, 1, 0); PG8_STAGE(PG8_SA(0, 1), a2 + hstep, voffA);
            PG8_WAIT_L(8); PG8_BAR; PG8_WAIT_L(0); PG8_MMA(0, 0, At, B0); PG8_BAR; PG8_SCHED;
            PG8_LDB(B1, 1, 1); PG8_STAGE(PG8_SB(1, 0), b3, voffB);
            PG8_BAR; PG8_WAIT_L(0); PG8_MMA(0, 1, At, B1); PG8_BAR;
            PG8_LDA(At, 1, 1); PG8_STAGE(PG8_SA(1, 0), a3, voffA);
            PG8_BAR; PG8_WAIT_L(0); PG8_MMA(1, 0, At, B0); PG8_BAR; PG8_SCHED;
            PG8_STAGE(PG8_SB(1, 1), b3 + hstep, voffB);
            PG8_WAIT_V(6); PG8_BAR; PG8_MMA(1, 1, At, B1); PG8_BAR;
            }
        }
        if constexpr (ALIGN_EPI) { if (wr == 0) PG8_BAR; }
        if constexpr (!Epi::AFTER_DRAIN) { E(acc, cur, wr, wc, fr, fq); S.done(cur); }
        if (!has_next) break;
#pragma unroll
        for (int a = 0; a < 2; ++a)
#pragma unroll
            for (int b = 0; b < 2; ++b)
#pragma unroll
                for (int m = 0; m < 4; ++m)
#pragma unroll
                    for (int n = 0; n < 2; ++n) acc[a][b][m][n] = (f32x4){0.f, 0.f, 0.f, 0.f};
        cur = nxt; cA = nA; cB = nB; ++ui;
        if constexpr (ALIGN_EPI) { if (wr == 1) PG8_BAR; }
    }
    PG8_WAIT_V(0);
    if constexpr (!ALIGN_EPI) { if (wr == 0) PG8_BAR; }
    PG8_BAR;
    if constexpr (Epi::AFTER_DRAIN) { E.fused(acc, cur, wr, wc, fr, fq, lds, wid, lane); S.done(cur); }
#undef PG8_SA
#undef PG8_SB
#undef PG8_STAGE
#undef PG8_LDA
#undef PG8_LDB
#undef PG8_MMA
#undef PG8_WAIT_V
#undef PG8_WAIT_L
#undef PG8_BAR
#undef PG8_SCHED
}
}
#define GAS __attribute__((address_space(1)))
#define LAS __attribute__((address_space(3)))
typedef unsigned short bf16;
typedef unsigned v4u __attribute__((ext_vector_type(4)));
typedef float f32x4 __attribute__((ext_vector_type(4)));
typedef short bf16x8 __attribute__((ext_vector_type(8)));
typedef GAS unsigned gu32;
typedef GAS unsigned long long gu64;
#define RLX_AGENT __ATOMIC_RELAXED, __HIP_MEMORY_SCOPE_AGENT
#define LDS_WAIT() asm volatile("s_waitcnt lgkmcnt(0)" ::: "memory")
#define VM_WAIT() asm volatile("s_waitcnt vmcnt(0)" ::: "memory")
__device__ __forceinline__ unsigned long long rt() { return __builtin_amdgcn_s_memrealtime(); }
__device__ __forceinline__ unsigned f2bf(float f) { unsigned u = __builtin_bit_cast(unsigned, f); return (u + 0x7fffu + ((u >> 16) & 1u)) >> 16; }
typedef float f32x2_cv __attribute__((ext_vector_type(2))); typedef __bf16 bf16x2_cv __attribute__((ext_vector_type(2)));
__device__ __forceinline__ unsigned pk2(float lo, float hi) { f32x2_cv v = {lo, hi}; bf16x2_cv b = __builtin_convertvector(v, bf16x2_cv); return __builtin_bit_cast(unsigned, b); }

#define XB_TMO      128
#define XB_XCNT(j)  (256  + 64 * (j))
#define XB_XSUB(j)  (1280 + 64 * (j))
#define XB_XGEN(j)  (2304 + 64 * (j))
#define XB_TOP      3328
#define XB_TOPGEN   3392
#define XCD_BAR_WORDS 3456
#define XB_SPIN_CAP (1u << 18)

__device__ __forceinline__ unsigned xb_ld(unsigned* p)              { return __hip_atomic_load(p, __ATOMIC_RELAXED, __HIP_MEMORY_SCOPE_AGENT); }
__device__ __forceinline__ unsigned xb_add(unsigned* p, unsigned v) { return __hip_atomic_fetch_add(p, v, __ATOMIC_RELAXED, __HIP_MEMORY_SCOPE_AGENT); }
__device__ __forceinline__ unsigned xb_xcc_id() { return (unsigned)__builtin_amdgcn_s_getreg((3 << 11) | 20) & 0xFu; }
#define XB_SPIN(cond, bar) do { unsigned _sp = 0; while (cond) { __builtin_amdgcn_s_sleep(1); \
    if ((++_sp & 255u) == 0u) { if (xb_ld(&(bar)[XB_TMO])) break; if (_sp > XB_SPIN_CAP) { atomicAdd(&(bar)[XB_TMO], 1u); break; } } } } while (0)

struct XcdBarrier {
    unsigned* bar; unsigned x;
    volatile LAS unsigned* st;
};

__device__ __forceinline__ XcdBarrier xcd_barrier_post(unsigned* bar, volatile LAS unsigned* st) {
    XcdBarrier b; b.bar = bar; b.x = xb_xcc_id(); b.st = st;
    if (threadIdx.x == 0) (void)xb_add(&bar[XB_XCNT(b.x)], 1u);
    return b;
}
__device__ __forceinline__ void xcd_barrier_complete(unsigned* bar, unsigned x, unsigned& nloc, unsigned& nx) {
    const unsigned G = gridDim.x * gridDim.y * gridDim.z;
    unsigned sum, cnt, mine, sp = 0u;
    for (;;) {
        sum = 0u; cnt = 0u; mine = 0u;
#pragma unroll
        for (unsigned j = 0; j < 16; ++j) { const unsigned c = xb_ld(&bar[XB_XCNT(j)]); sum += c; cnt += (c > 0u) ? 1u : 0u; mine = (j == x) ? c : mine; }
        if (sum == G) break;
        __builtin_amdgcn_s_sleep(1);
        if ((++sp & 255u) == 0u) { if (xb_ld(&bar[XB_TMO])) break; if (sp > XB_SPIN_CAP) { atomicAdd(&bar[XB_TMO], 1u); break; } }
    }
    nloc = mine > 0u ? mine : 1u; nx = cnt > 0u ? cnt : 1u;
}

__device__ __forceinline__ void xcd_barrier(const XcdBarrier& b) {
    asm volatile("s_waitcnt vmcnt(0)" ::: "memory");
    __syncthreads();
    if (threadIdx.x == 0) {
        unsigned* bar = b.bar;
        __builtin_amdgcn_s_waitcnt(0);
        unsigned nloc = b.st[0], nx = b.st[1];
        if (nloc == 0u) { xcd_barrier_complete(bar, b.x, nloc, nx); b.st[0] = nloc; b.st[1] = nx; }
        const unsigned old = xb_add(&bar[XB_XSUB(b.x)], 1u);
        const unsigned gen = old / nloc;
        if (old + 1u == (gen + 1u) * nloc) {
            __builtin_amdgcn_fence(__ATOMIC_RELEASE, "agent");
            asm volatile("s_waitcnt vmcnt(0)" ::: "memory");
            const unsigned og = xb_add(&bar[XB_TOP], 1u);
            const unsigned tg = og / nx;
            if (og + 1u == (tg + 1u) * nx) xb_add(&bar[XB_TOPGEN], 1u);
            else XB_SPIN(xb_ld(&bar[XB_TOPGEN]) == tg, bar);
            __builtin_amdgcn_fence(__ATOMIC_ACQUIRE, "agent");
            xb_add(&bar[XB_XGEN(b.x)], 1u);
            asm volatile("s_waitcnt vmcnt(0)" ::: "memory");
        } else {
            XB_SPIN(xb_ld(&bar[XB_XGEN(b.x)]) == gen, bar);
            __builtin_amdgcn_fence(__ATOMIC_ACQUIRE, "agent");
            asm volatile("s_waitcnt vmcnt(0)" ::: "memory");
        }
    }
    __syncthreads();
}

constexpr int NWAVES = 8;
#ifndef MK_N_LAUNCHES
#define MK_N_LAUNCHES 1
#endif
constexpr int NPHASE = 10;
constexpr int N_LAUNCHES = MK_N_LAUNCHES;

constexpr int BATCH = 2, SEQ = 8192, DM = 2048, M = BATCH * SEQ, NH = 16, HD = 64;
constexpr int N1 = 8704, IN_W = 8480, NLORA = 3072, KLORA = 384;
constexpr float NORM_EPS = 1e-5f, LNX_EPS = 64e-5f;
constexpr float C2Q = 0.125f * 1.4426950408889634f;

constexpr size_t MiB = 1u << 20;
constexpr size_t WS_CTL = 0, CTL_ZERO_BYTES = 1 * MiB;
constexpr size_t WS_COS = 1 * MiB, WS_SIN = 2 * MiB;
constexpr size_t WS_BTL = 3 * MiB;
constexpr size_t WS_SSQ = 6 * MiB;
constexpr size_t WS_BT2 = 8 * MiB;
constexpr size_t WS_BT1 = 16 * MiB;
constexpr size_t WS_XN = 50 * MiB;
constexpr size_t WS_OP = 16 * MiB;
constexpr size_t WS_XL = 16 * MiB;
constexpr size_t WS_SA = 114 * MiB;
constexpr size_t WS_SB = 242 * MiB;
constexpr size_t WS_SC = 338 * MiB;
constexpr size_t WS_SD = 370 * MiB;
constexpr size_t WS_MIX = 386 * MiB;
constexpr size_t WS_AL = 450 * MiB;
constexpr size_t WS_LSE = 462 * MiB;
constexpr size_t WS_END = 512 * MiB;
constexpr int CW_BAR = 4096;

constexpr int RING_BYTES = 131072, LDSCTL_OFF = RING_BYTES, MISC_OFF = LDSCTL_OFF + 320, LDS_BYTES = 147456;

typedef float f32x16 __attribute__((ext_vector_type(16)));
typedef short s16x4 __attribute__((ext_vector_type(4)));
typedef unsigned u32x2 __attribute__((ext_vector_type(2)));

__device__ __forceinline__ float wave_sum(float v) {
#pragma unroll
    for (int o = 1; o < 64; o <<= 1) v += __shfl_xor(v, o);
    return v;
}
__device__ __forceinline__ float bf2f(unsigned short b) { return __builtin_bit_cast(float, (unsigned)b << 16); }
__device__ __forceinline__ float bflo(unsigned w) { return __builtin_bit_cast(float, w << 16); }
__device__ __forceinline__ float bfhi(unsigned w) { return __builtin_bit_cast(float, w & 0xffff0000u); }
__device__ __forceinline__ float sigmoidf_(float x) { return __builtin_amdgcn_rcpf(1.0f + __expf(-x)); }
__device__ __forceinline__ float siluf_(float x) { return x * sigmoidf_(x); }
__device__ __forceinline__ void unpack8(const v4u w, float (&f)[8]) {
    f[0] = bflo(w.x); f[1] = bfhi(w.x); f[2] = bflo(w.y); f[3] = bfhi(w.y); f[4] = bflo(w.z); f[5] = bfhi(w.z); f[6] = bflo(w.w); f[7] = bfhi(w.w);
}
__device__ __forceinline__ v4u pack8(const float (&f)[8]) { v4u w; w.x = pk2(f[0], f[1]); w.y = pk2(f[2], f[3]); w.z = pk2(f[4], f[5]); w.w = pk2(f[6], f[7]); return w; }
__device__ __forceinline__ float red8(float x) {
    x += __builtin_bit_cast(float, __builtin_amdgcn_update_dpp(0, __builtin_bit_cast(int, x), 0x141, 0xf, 0xf, true));
    x += __builtin_bit_cast(float, __builtin_amdgcn_update_dpp(0, __builtin_bit_cast(int, x), 0xB1, 0xf, 0xf, true));
    x += __builtin_bit_cast(float, __builtin_amdgcn_update_dpp(0, __builtin_bit_cast(int, x), 0x4E, 0xf, 0xf, true));
    return x;
}

struct Frame {
    LAS unsigned char* lds;
    int tid, lane, wave, vcu, G;
    const float *x, *norm_g, *w_in, *shift_mu, *w0, *w2, *a0, *a2, *g2, *k_k, *k_a, *r_k, *lnx_g, *lnx_b, *w_out, *final_g;
    float* out; unsigned char* ws;
};

__device__ __forceinline__ int gemm1_row_of_col(int o) {
    if (o < 2048) { const int d = o & 63, base = o - d; return base + (d < 32 ? 8 * (d >> 2) + (d & 3) : 8 * ((d - 32) >> 2) + 4 + (d & 3)); }
    if (o < 7168) return o;
    if (o < 7456) return o + 1024;
    return o - 288;
}
template <bool MAP>
__device__ __forceinline__ void transpose_item(const float* W, int K, int N, bf16* WT, LAS float* scr, int item, int lane) {
    const int nblk = N / 32, kb = item / nblk, nb = item % nblk, k0 = 64 * kb, n0 = 32 * nb;
#pragma unroll 8
    for (int i = 0; i < 32; ++i) { const int kk = 2 * i + (lane >> 5); scr[kk * 33 + (lane & 31)] = W[(size_t)(k0 + kk) * N + n0 + (lane & 31)]; }
    LDS_WAIT(); asm volatile("" ::: "memory");
    const int c = lane & 7;
#pragma unroll
    for (int j = 0; j < 4; ++j) { const int n = (lane >> 3) + 8 * j; const LAS float* s = scr + (8 * c) * 33 + n;
        v4u o; o.x = pk2(s[0 * 33], s[1 * 33]); o.y = pk2(s[2 * 33], s[3 * 33]); o.z = pk2(s[4 * 33], s[5 * 33]); o.w = pk2(s[6 * 33], s[7 * 33]);
        const int row = MAP ? gemm1_row_of_col(n0 + n) : (n0 + n);
        *(GAS v4u*)(WT + (size_t)row * K + k0 + 8 * c) = o; }
    LDS_WAIT(); asm volatile("" ::: "memory");
}
__device__ __forceinline__ void rms_row_to_bf16(const float* xrow, const float* g, bf16* orow, int lane) {
    const GAS f32x4* xr = (const GAS f32x4*)xrow + lane; const GAS f32x4* gr = (const GAS f32x4*)g + lane;
    f32x4 v[8]; float s = 0.f;
#pragma unroll
    for (int j = 0; j < 8; ++j) { v[j] = xr[64 * j]; s += (v[j].x * v[j].x + v[j].y * v[j].y) + (v[j].z * v[j].z + v[j].w * v[j].w); }
    const float rs = 1.0f / sqrtf(wave_sum(s) * (1.0f / DM) + NORM_EPS);
    GAS u32x2* o8 = (GAS u32x2*)orow + lane;
#pragma unroll
    for (int j = 0; j < 8; ++j) { const f32x4 gv = gr[64 * j]; u32x2 w; w.x = pk2(v[j].x * rs * gv.x, v[j].y * rs * gv.y); w.y = pk2(v[j].z * rs * gv.z, v[j].w * rs * gv.w); o8[64 * j] = w; }
}
__device__ __forceinline__ void p0_prologue(Frame& F) {
    LAS float* scr = (LAS float*)(F.lds + F.wave * 16384);
    const int gw = F.vcu * NWAVES + F.wave, NGW = F.G * NWAVES;
    const int gt = gw * 64 + F.lane, NGT = NGW * 64;
    bf16* BT1 = (bf16*)(F.ws + WS_BT1); bf16* BT2 = (bf16*)(F.ws + WS_BT2); bf16* BTL = (bf16*)(F.ws + WS_BTL); bf16* XN = (bf16*)(F.ws + WS_XN);
    constexpr int I_1 = (DM / 64) * (IN_W / 32), I_2 = (DM / 64) * (DM / 32);
    for (int it = gw; it < I_1 + I_2; it += NGW) {
        if (it < I_1) transpose_item<true>(F.w_in, DM, IN_W, BT1, scr, it, F.lane);
        else transpose_item<false>(F.w_out, DM, DM, BT2, scr, it - I_1, F.lane);
    }
    for (int i = gt; i < (N1 - IN_W) * DM / 8; i += NGT) ((GAS v4u*)(BT1 + (size_t)IN_W * DM))[i] = (v4u){0u, 0u, 0u, 0u};
    for (int i = gt; i < KLORA * 1024; i += NGT) { const int k = i >> 10, ch = i & 1023;
        const float vw = (k < 64) ? F.w2[k * 1024 + ch] : 0.f, va = (k >= 64 && k < 128) ? F.a2[(k - 64) * 1024 + ch] : 0.f, vg = (k >= 128 && k < 288) ? F.g2[(k - 128) * 1024 + ch] : 0.f;
        BTL[(size_t)ch * KLORA + k] = (bf16)f2bf(vw); BTL[(size_t)(1024 + ch) * KLORA + k] = (bf16)f2bf(va); BTL[(size_t)(2048 + ch) * KLORA + k] = (bf16)f2bf(vg); }
    { float* ct = (float*)(F.ws + WS_COS); float* st = (float*)(F.ws + WS_SIN);
      for (int i = gt; i < SEQ * 32; i += NGT) { const int pos = i >> 5, fi = i & 31;
          const double rev = (double)pos * exp2(-(double)fi * (13.287712379549449 / 32.0)) * 0.15915494309189535;
          const float fr = (float)(rev - floor(rev));
          ct[i] = __builtin_amdgcn_cosf(fr); st[i] = __builtin_amdgcn_sinf(fr); } }
    for (int m = gw; m < M; m += NGW) rms_row_to_bf16(F.x + (size_t)m * DM, F.norm_g, XN + (size_t)m * DM, F.lane);
}

struct EpiProj {
    static constexpr bool PERM = true, AFTER_DRAIN = false;
    pg8::bf16_t *SA, *SB, *SC, *SD; const float* cosT; const float* sinT;
    __device__ __forceinline__ void operator()(const pg8::f32x4 (&acc)[2][2][4][2], const pg8::Unit& u, int wr, int wc, int fr, int fq) const {
        const int pn = u.pn; pg8::bf16_t* base; int ld, colt, kind;
        if (pn < 16) { base = SA; ld = 4096; colt = 256 * pn; kind = pn < 4 ? 0 : pn < 8 ? 1 : pn < 12 ? 2 : 3; }
        else if (pn < 28) { base = SB; ld = 3072; colt = 256 * (pn - 16); kind = 2; }
        else if (pn < 32) { base = SC; ld = 1024; colt = 256 * (pn - 28); kind = 3; }
        else { base = SD; ld = 512; colt = 256 * (pn - 32); kind = 2; }
        const int row0 = u.pm * 256 + wr * 64 + fr, col0 = colt + wc * 32 + 8 * fq, e4 = 4 * (4 * (wc & 1) + fq);
#pragma unroll
        for (int ai = 0; ai < 2; ++ai)
#pragma unroll
            for (int m = 0; m < 4; ++m) { const int row = row0 + ai * 128 + m * 16; pg8::bf16_t* rowp = base + (size_t)row * ld + col0;
                pg8::f32x4 cs = {1.f, 1.f, 1.f, 1.f}, sn = {0.f, 0.f, 0.f, 0.f};
                if (kind <= 1) { const int pos = row & (SEQ - 1); cs = *(const pg8::f32x4*)(cosT + pos * 32 + e4); sn = *(const pg8::f32x4*)(sinT + pos * 32 + e4); }
#pragma unroll
                for (int bj = 0; bj < 2; ++bj) { pg8::f32x4 v0 = acc[ai][bj][m][0], v1 = acc[ai][bj][m][1];
                    if (kind <= 1) { const pg8::f32x4 o0 = v0 * cs - v1 * sn, o1 = v1 * cs + v0 * sn; const float s = kind == 0 ? C2Q : 1.0f; v0 = o0 * s; v1 = o1 * s; }
                    else if (kind == 3) {
#pragma unroll
                        for (int i = 0; i < 4; ++i) { v0[i] = siluf_(v0[i]); v1[i] = siluf_(v1[i]); } }
                    pg8::u32x4 w; w.x = pg8::cvt_pk_bf16(v0[0], v0[1]); w.y = pg8::cvt_pk_bf16(v0[2], v0[3]); w.z = pg8::cvt_pk_bf16(v1[0], v1[1]); w.w = pg8::cvt_pk_bf16(v1[2], v1[3]);
                    *(pg8::u32x4*)(rowp + bj * 128) = w; } }
    }
};
struct EpiOut {
    static constexpr bool PERM = false, AFTER_DRAIN = false;
    const float* x; float* out; float* ssq;
    __device__ __forceinline__ void operator()(const pg8::f32x4 (&acc)[2][2][4][2], const pg8::Unit& u, int wr, int wc, int fr, int fq) const {
        const int row0 = u.pm * 256 + wr * 64 + fr, col0 = u.pn * 256 + wc * 32 + 4 * fq;
#pragma unroll
        for (int ai = 0; ai < 2; ++ai)
#pragma unroll
            for (int m = 0; m < 4; ++m) { const int row = row0 + ai * 128 + m * 16; const size_t off = (size_t)row * DM + col0; float s = 0.f;
#pragma unroll
                for (int bj = 0; bj < 2; ++bj)
#pragma unroll
                    for (int n = 0; n < 2; ++n) { const pg8::f32x4 y = *(const pg8::f32x4*)(x + off + bj * 128 + n * 16) + acc[ai][bj][m][n];
                        *(pg8::f32x4*)(out + off + bj * 128 + n * 16) = y; s += (y[0] * y[0] + y[1] * y[1]) + (y[2] * y[2] + y[3] * y[3]); }
                s += __shfl_xor(s, 16); s += __shfl_xor(s, 32);
                if (fq == 0) ssq[(size_t)row * 32 + u.pn * 4 + wc] = s; }
    }
};

constexpr int ATT_VP = 192;
constexpr int ATT_WLDS = 32 * ATT_VP + 4096 + 256;
__device__ __forceinline__ int crow(int r, int hi) { return (r & 3) + 8 * (r >> 2) + 4 * hi; }
__device__ __forceinline__ s16x4 vtr(const LAS unsigned char* p) { return __builtin_bit_cast(s16x4, __builtin_amdgcn_ds_read_tr16_b64_v4i16((LAS s16x4*)p)); }

__device__ __forceinline__ void attn_item(const bf16* SA, int dil, int b, int h, int r, int m0, bf16* Op, float* Lp, LAS unsigned char* wl, int lane) {
    const int q32 = lane & 31, hi = lane >> 5;
    const size_t tokb = (size_t)b * SEQ;
    const bf16* qrow = SA + (tokb + (size_t)(m0 + q32) * dil + r) * 4096 + h * 64;
    bf16x8 qf[4];
#pragma unroll
    for (int s = 0; s < 4; ++s) qf[s] = *(const bf16x8*)(qrow + 16 * s + 8 * hi);
    const int tmin = m0 >= 128 ? 0 : (128 - m0) >> 5;
    f32x16 sc[5];
#pragma unroll
    for (int t = 0; t < 5; ++t) {
        if (t < tmin) {
#pragma unroll
            for (int i = 0; i < 16; ++i) sc[t][i] = -INFINITY;
        } else {
            const bf16* krow = SA + (tokb + (size_t)(m0 - 128 + 32 * t + q32) * dil + r) * 4096 + 1024 + h * 64;
            bf16x8 kf[4];
#pragma unroll
            for (int s = 0; s < 4; ++s) kf[s] = *(const bf16x8*)(krow + 16 * s + 8 * hi);
            f32x16 a = {};
#pragma unroll
            for (int s = 0; s < 4; ++s) a = __builtin_amdgcn_mfma_f32_32x32x16_bf16(kf[s], qf[s], a, 0, 0, 0);
            if (t == 0) {
#pragma unroll
                for (int i = 0; i < 16; ++i) if (crow(i, hi) < q32) a[i] = -INFINITY;
            }
            if (t == 4) {
#pragma unroll
                for (int i = 0; i < 16; ++i) if (crow(i, hi) > q32) a[i] = -INFINITY;
            }
            sc[t] = a;
        }
    }
    float mx = -INFINITY;
#pragma unroll
    for (int t = 0; t < 5; ++t)
#pragma unroll
        for (int i = 0; i < 16; ++i) mx = fmaxf(mx, sc[t][i]);
    mx = fmaxf(mx, __shfl_xor(mx, 32));
    float l = 0.f;
#pragma unroll
    for (int t = 0; t < 5; ++t)
#pragma unroll
        for (int i = 0; i < 16; ++i) { const float p = __builtin_amdgcn_exp2f(sc[t][i] - mx); sc[t][i] = p; l += p; }
    l += __shfl_xor(l, 32);
    LAS float* wsf = (LAS float*)(wl + 32 * ATT_VP + 4096);
    if (hi == 0) wsf[q32] = __builtin_amdgcn_rcpf(l);
    f32x16 o[2]; o[0] = f32x16{}; o[1] = f32x16{};
    const LAS unsigned char* vrd = wl + (4 * hi + ((lane & 15) >> 2)) * ATT_VP + ((lane >> 4) & 1) * 32 + (lane & 3) * 8;
#pragma unroll
    for (int t = 0; t < 5; ++t) {
        if (t >= tmin) {
#pragma unroll
            for (int i = 0; i < 4; ++i) { const int row = (lane >> 3) + 8 * i, ch = lane & 7;
                const v4u v = *(const GAS v4u*)(SA + (tokb + (size_t)(m0 - 128 + 32 * t + row) * dil + r) * 4096 + 2048 + h * 64 + ch * 8);
                *(LAS v4u*)(wl + row * ATT_VP + ch * 16) = v; }
            LDS_WAIT(); asm volatile("" ::: "memory");
#pragma unroll
            for (int s2 = 0; s2 < 2; ++s2) {
                v4u pw; pw.x = pk2(sc[t][8 * s2 + 0], sc[t][8 * s2 + 1]); pw.y = pk2(sc[t][8 * s2 + 2], sc[t][8 * s2 + 3]); pw.z = pk2(sc[t][8 * s2 + 4], sc[t][8 * s2 + 5]); pw.w = pk2(sc[t][8 * s2 + 6], sc[t][8 * s2 + 7]);
                const bf16x8 pa = __builtin_bit_cast(bf16x8, pw);
#pragma unroll
                for (int db = 0; db < 2; ++db) {
                    const s16x4 lo = vtr(vrd + (16 * s2) * ATT_VP + db * 64), hh = vtr(vrd + (16 * s2 + 8) * ATT_VP + db * 64);
                    const bf16x8 vb = {lo[0], lo[1], lo[2], lo[3], hh[0], hh[1], hh[2], hh[3]};
                    o[db] = __builtin_amdgcn_mfma_f32_32x32x16_bf16(pa, vb, o[db], 0, 0, 0);
                }
            }
            LDS_WAIT(); asm volatile("" ::: "memory");
        }
    }
    LAS bf16* stg = (LAS bf16*)(wl + 32 * ATT_VP);
#pragma unroll
    for (int i = 0; i < 16; ++i) { const int q = crow(i, hi); const float li = wsf[q];
        stg[q * 64 + q32] = (bf16)f2bf(o[0][i] * li); stg[q * 64 + 32 + q32] = (bf16)f2bf(o[1][i] * li); }
    LDS_WAIT(); asm volatile("" ::: "memory");
#pragma unroll
    for (int i = 0; i < 4; ++i) { const int row = i * 8 + (lane >> 3), ch = lane & 7; const v4u v = *(const LAS v4u*)(stg + row * 64 + ch * 8);
        *(GAS v4u*)(Op + (tokb + (size_t)(m0 + row) * dil + r) * 1024 + h * 64 + ch * 8) = v; }
    if (hi == 0) Lp[(tokb + (size_t)(m0 + q32) * dil + r) * 16 + h] = mx + __builtin_amdgcn_logf(l);
    LDS_WAIT(); asm volatile("" ::: "memory");
}
constexpr int ATK_OFF = 0, ATV_OFF = 49152, ATO_OFF = 98304, ATW_OFF = MISC_OFF + 128;
__device__ __forceinline__ void attn_decode(int it, int& dil, int& b, int& h, int& r, int& M0) {
    const int pat = it >> 10, rem = it & 1023, bh = rem >> 5, bi = rem & 31;
    dil = pat == 0 ? 1 : pat == 1 ? 4 : 16; const int bpc = 32 / dil;
    b = bh >> 4; h = bh & 15; r = bi / bpc; M0 = 256 * (bi % bpc);
}
__device__ __forceinline__ void attn_fetch(const bf16* SA, int it, int tid, v4u (&kr)[6], v4u (&vr)[6]) {
    int dil, b, h, r, M0; attn_decode(it, dil, b, h, r, M0);
#pragma unroll
    for (int i = 0; i < 6; ++i) { const int p = tid + 512 * i, row = p >> 3, ch = p & 7, ci = M0 - 128 + row;
        if (ci >= 0) { const bf16* src = SA + ((size_t)b * SEQ + (size_t)ci * dil + r) * 4096 + h * 64 + ch * 8;
            kr[i] = *(const GAS v4u*)(src + 1024); vr[i] = *(const GAS v4u*)(src + 2048); }
        else { kr[i] = (v4u){0u, 0u, 0u, 0u}; vr[i] = (v4u){0u, 0u, 0u, 0u}; } }
}
__device__ __forceinline__ void attn_phase(Frame& F) {
    const bf16* SA = (const bf16*)(F.ws + WS_SA);
    LAS unsigned char* L = F.lds; const int tid = F.tid, lane = F.lane, w = F.wave, q32 = lane & 31, hi = lane >> 5;
    constexpr int NIT = 3 * 1024;
    v4u kr[6], vr[6];
    int it = F.vcu;
    if (it < NIT) attn_fetch(SA, it, tid, kr, vr);
    for (; it < NIT; it += F.G) {
        int dil, b, h, r, M0; attn_decode(it, dil, b, h, r, M0);
        const int pat = it >> 10;
        bf16* Op = (bf16*)(F.ws + WS_OP) + (size_t)pat * M * 1024; float* Lp = (float*)(F.ws + WS_LSE) + (size_t)pat * M * 16;
#pragma unroll
        for (int i = 0; i < 6; ++i) { const int p = tid + 512 * i, row = p >> 3, ch = p & 7;
            *(LAS v4u*)(L + ATK_OFF + row * 128 + ((ch ^ (row & 7)) << 4)) = kr[i]; *(LAS v4u*)(L + ATV_OFF + row * 128 + (ch << 4)) = vr[i]; }
        const size_t tokb = (size_t)b * SEQ; const int m0 = M0 + 32 * w;
        const bf16* qrow = SA + (tokb + (size_t)(m0 + q32) * dil + r) * 4096 + h * 64;
        bf16x8 qf[4];
#pragma unroll
        for (int s = 0; s < 4; ++s) qf[s] = *(const bf16x8*)(qrow + 16 * s + 8 * hi);
        __syncthreads();
        if (it + F.G < NIT) attn_fetch(SA, it + F.G, tid, kr, vr);
        const int tmin = m0 >= 128 ? 0 : (128 - m0) >> 5;
        f32x16 sc[5];
#pragma unroll
        for (int t = 0; t < 5; ++t) {
            if (t < tmin) {
#pragma unroll
                for (int i = 0; i < 16; ++i) sc[t][i] = -INFINITY;
            } else {
                const int krow = 32 * (w + t) + q32; const LAS unsigned char* kp = L + ATK_OFF + krow * 128;
                f32x16 a = {};
#pragma unroll
                for (int s = 0; s < 4; ++s) { const bf16x8 kf = *(const LAS bf16x8*)(kp + (((2 * s + hi) ^ (krow & 7)) << 4)); a = __builtin_amdgcn_mfma_f32_32x32x16_bf16(kf, qf[s], a, 0, 0, 0); }
                if (t == 0) {
#pragma unroll
                    for (int i = 0; i < 16; ++i) if (crow(i, hi) < q32) a[i] = -INFINITY;
                }
                if (t == 4) {
#pragma unroll
                    for (int i = 0; i < 16; ++i) if (crow(i, hi) > q32) a[i] = -INFINITY;
                }
                sc[t] = a;
            }
        }
        float mx = -INFINITY;
#pragma unroll
        for (int t = 0; t < 5; ++t)
#pragma unroll
            for (int i = 0; i < 16; ++i) mx = fmaxf(mx, sc[t][i]);
        mx = fmaxf(mx, __shfl_xor(mx, 32));
        float l = 0.f;
#pragma unroll
        for (int t = 0; t < 5; ++t)
#pragma unroll
            for (int i = 0; i < 16; ++i) { const float p = __builtin_amdgcn_exp2f(sc[t][i] - mx); sc[t][i] = p; l += p; }
        l += __shfl_xor(l, 32);
        LAS float* wsf = (LAS float*)(L + ATW_OFF) + 32 * w;
        if (hi == 0) wsf[q32] = __builtin_amdgcn_rcpf(l);
        f32x16 o[2]; o[0] = f32x16{}; o[1] = f32x16{};
        const LAS unsigned char* vrd = L + ATV_OFF + (32 * w + 4 * hi + ((lane & 15) >> 2)) * 128 + ((lane >> 4) & 1) * 32 + (lane & 3) * 8;
#pragma unroll
        for (int t = 0; t < 5; ++t) {
            if (t >= tmin) {
#pragma unroll
                for (int s2 = 0; s2 < 2; ++s2) {
                    v4u pw; pw.x = pk2(sc[t][8 * s2 + 0], sc[t][8 * s2 + 1]); pw.y = pk2(sc[t][8 * s2 + 2], sc[t][8 * s2 + 3]); pw.z = pk2(sc[t][8 * s2 + 4], sc[t][8 * s2 + 5]); pw.w = pk2(sc[t][8 * s2 + 6], sc[t][8 * s2 + 7]);
                    const bf16x8 pa = __builtin_bit_cast(bf16x8, pw);
#pragma unroll
                    for (int db = 0; db < 2; ++db) {
                        const s16x4 lo = vtr(vrd + (32 * t + 16 * s2) * 128 + db * 64), hh = vtr(vrd + (32 * t + 16 * s2 + 8) * 128 + db * 64);
                        const bf16x8 vb = {lo[0], lo[1], lo[2], lo[3], hh[0], hh[1], hh[2], hh[3]};
                        o[db] = __builtin_amdgcn_mfma_f32_32x32x16_bf16(pa, vb, o[db], 0, 0, 0);
                    }
                }
            }
        }
        LAS bf16* stg = (LAS bf16*)(L + ATO_OFF + 4096 * w);
#pragma unroll
        for (int i = 0; i < 16; ++i) { const int q = crow(i, hi); const float li = wsf[q];
            stg[q * 64 + q32] = (bf16)f2bf(o[0][i] * li); stg[q * 64 + 32 + q32] = (bf16)f2bf(o[1][i] * li); }
        LDS_WAIT(); asm volatile("" ::: "memory");
#pragma unroll
        for (int i = 0; i < 4; ++i) { const int row = i * 8 + (lane >> 3), ch = lane & 7; const v4u v = *(const LAS v4u*)(stg + row * 64 + ch * 8);
            *(GAS v4u*)(Op + (tokb + (size_t)(m0 + row) * dil + r) * 1024 + h * 64 + ch * 8) = v; }
        if (hi == 0) Lp[(tokb + (size_t)(m0 + q32) * dil + r) * 16 + h] = mx + __builtin_amdgcn_logf(l);
        __syncthreads();
    }
}
__device__ __forceinline__ void lora_act_phase(Frame& F) {
    const bf16* SD = (const bf16*)(F.ws + WS_SD); bf16* AL = (bf16*)(F.ws + WS_AL);
    const int gt = (F.vcu * NWAVES + F.wave) * 64 + F.lane, NGT = F.G * NWAVES * 64;
    for (int i = gt; i < M * (KLORA / 8); i += NGT) { const int m = i / (KLORA / 8), c8 = (i % (KLORA / 8)) * 8;
        v4u o = {0u, 0u, 0u, 0u};
        if (c8 < 288) {
            float cur[8], prv[8], f[8];
            unpack8(*(const GAS v4u*)(SD + (size_t)m * 512 + c8), cur);
            if ((m & (SEQ - 1)) != 0) unpack8(*(const GAS v4u*)(SD + (size_t)(m - 1) * 512 + c8), prv);
            else {
#pragma unroll
                for (int e = 0; e < 8; ++e) prv[e] = 0.f; }
#pragma unroll
            for (int e = 0; e < 8; ++e) { const float mu = F.shift_mu[3072 + c8 + e]; const float xs = cur[e] + (prv[e] - cur[e]) * mu;
                f[e] = c8 < 64 ? tanhf(xs) : c8 < 128 ? xs : sigmoidf_(xs); }
            o = pack8(f);
        }
        *(GAS v4u*)(AL + (size_t)m * KLORA + c8) = o; }
}
__device__ __forceinline__ void combine_phase(Frame& F) {
    const bf16* SA = (const bf16*)(F.ws + WS_SA); const bf16* OP = (const bf16*)(F.ws + WS_OP); const float* LS = (const float*)(F.ws + WS_LSE); bf16* MIX = (bf16*)(F.ws + WS_MIX);
    const int gt = (F.vcu * NWAVES + F.wave) * 64 + F.lane, NGT = F.G * NWAVES * 64;
    for (int i = gt; i < M * 128; i += NGT) { const int m = i >> 7, c8 = (i & 127) * 8, h = c8 >> 6;
        const float l0 = LS[(size_t)m * 16 + h], l1 = LS[(size_t)(M + m) * 16 + h], l2 = LS[(size_t)(2 * M + m) * 16 + h];
        const float mx = fmaxf(l0, fmaxf(l1, l2));
        float w0 = __builtin_amdgcn_exp2f(l0 - mx), w1 = __builtin_amdgcn_exp2f(l1 - mx), w2 = __builtin_amdgcn_exp2f(l2 - mx);
        const float inv = 1.0f / (w0 + w1 + w2); w0 *= inv; w1 *= inv; w2 *= inv;
        float a[8], bq[8], c[8], z[8], f[8];
        unpack8(*(const GAS v4u*)(OP + (size_t)m * 1024 + c8), a); unpack8(*(const GAS v4u*)(OP + (size_t)(M + m) * 1024 + c8), bq); unpack8(*(const GAS v4u*)(OP + (size_t)(2 * M + m) * 1024 + c8), c);
        unpack8(*(const GAS v4u*)(SA + (size_t)m * 4096 + 3072 + c8), z);
#pragma unroll
        for (int e = 0; e < 8; ++e) f[e] = (w0 * a[e] + w1 * bq[e] + w2 * c[e]) * z[e];
        *(GAS v4u*)(MIX + (size_t)m * 2048 + c8) = pack8(f); }
}
__device__ __forceinline__ void rwkv_seq_phase(Frame& F) {
    if (F.vcu >= BATCH * NH) return;
    const int b = F.vcu >> 4, h = F.vcu & 15, tid = F.tid;
    const bf16* SB = (const bf16*)(F.ws + WS_SB); const bf16* SC = (const bf16*)(F.ws + WS_SC); const bf16* XL = (const bf16*)(F.ws + WS_XL); bf16* MIX = (bf16*)(F.ws + WS_MIX);
    LAS float* LR = (LAS float*)F.lds; LAS float* LW = LR + 4096; LAS float* LK = LW + 4096; LAS float* LA = LK + 4096; LAS float* LB = LA + 4096; LAS float* LV = LB + 4096; LAS float* LY = LV + 4096;
    const int tok = tid >> 3, cg = tid & 7, ch0 = h * 64 + 8 * cg;
    float mu_r[8], mu_k[8], mu_v[8], w0v[8], a0v[8], kkv[8], kav[8], rkv[8], lg[8], lb[8];
#pragma unroll
    for (int e = 0; e < 8; ++e) { mu_r[e] = F.shift_mu[ch0 + e]; mu_k[e] = F.shift_mu[1024 + ch0 + e]; mu_v[e] = F.shift_mu[2048 + ch0 + e]; w0v[e] = F.w0[ch0 + e]; a0v[e] = F.a0[ch0 + e];
        kkv[e] = F.k_k[ch0 + e]; kav[e] = F.k_a[ch0 + e]; rkv[e] = F.r_k[ch0 + e]; lg[e] = F.lnx_g[ch0 + e]; lb[e] = F.lnx_b[ch0 + e]; }
    float st[8];
#pragma unroll
    for (int e = 0; e < 8; ++e) st[e] = 0.f;
    for (int c = 0; c < SEQ / 64; ++c) {
        const size_t m = (size_t)b * SEQ + c * 64 + tok;
        {
            float r[8], k[8], v[8], pr[8], pk[8], pv[8], xw[8], xa[8];
            unpack8(*(const GAS v4u*)(SB + m * 3072 + ch0), r); unpack8(*(const GAS v4u*)(SB + m * 3072 + 1024 + ch0), k); unpack8(*(const GAS v4u*)(SB + m * 3072 + 2048 + ch0), v);
            if (c * 64 + tok != 0) { unpack8(*(const GAS v4u*)(SB + (m - 1) * 3072 + ch0), pr); unpack8(*(const GAS v4u*)(SB + (m - 1) * 3072 + 1024 + ch0), pk); unpack8(*(const GAS v4u*)(SB + (m - 1) * 3072 + 2048 + ch0), pv); }
            else {
#pragma unroll
                for (int e = 0; e < 8; ++e) { pr[e] = 0.f; pk[e] = 0.f; pv[e] = 0.f; } }
            unpack8(*(const GAS v4u*)(XL + m * 3072 + ch0), xw); unpack8(*(const GAS v4u*)(XL + m * 3072 + 1024 + ch0), xa);
            float kk[8], ss = 0.f, as[8];
#pragma unroll
            for (int e = 0; e < 8; ++e) { r[e] += (pr[e] - r[e]) * mu_r[e]; k[e] += (pk[e] - k[e]) * mu_k[e]; v[e] += (pv[e] - v[e]) * mu_v[e];
                as[e] = sigmoidf_(a0v[e] + xa[e]); kk[e] = k[e] * kkv[e]; ss += kk[e] * kk[e]; }
            ss = red8(ss); const float inv = 1.0f / fmaxf(sqrtf(ss), 1e-12f);
#pragma unroll
            for (int e = 0; e < 8; ++e) { const float kn = kk[e] * inv; const int o = tok * 64 + 8 * cg + e;
                LR[o] = r[e]; LW[o] = __expf(-0.6065306597126334f * sigmoidf_(w0v[e] + xw[e])); LK[o] = k[e] * (1.0f + (as[e] - 1.0f) * kav[e]); LA[o] = -kn; LB[o] = kn * as[e]; LV[o] = v[e]; }
        }
        __syncthreads();
        {
            const int i = tid >> 3, jo = 8 * (tid & 7);
            for (int t = 0; t < 64; ++t) {
                const f32x4 a0 = *(const LAS f32x4*)(LA + t * 64 + jo), a1 = *(const LAS f32x4*)(LA + t * 64 + jo + 4);
                float sa = (st[0] * a0[0] + st[1] * a0[1]) + (st[2] * a0[2] + st[3] * a0[3]) + (st[4] * a1[0] + st[5] * a1[1]) + (st[6] * a1[2] + st[7] * a1[3]);
                sa = red8(sa);
                const f32x4 w0_ = *(const LAS f32x4*)(LW + t * 64 + jo), w1_ = *(const LAS f32x4*)(LW + t * 64 + jo + 4);
                const f32x4 b0 = *(const LAS f32x4*)(LB + t * 64 + jo), b1 = *(const LAS f32x4*)(LB + t * 64 + jo + 4);
                const f32x4 k0 = *(const LAS f32x4*)(LK + t * 64 + jo), k1 = *(const LAS f32x4*)(LK + t * 64 + jo + 4);
                const f32x4 r0 = *(const LAS f32x4*)(LR + t * 64 + jo), r1 = *(const LAS f32x4*)(LR + t * 64 + jo + 4);
                const float vi = LV[t * 64 + i];
#pragma unroll
                for (int e = 0; e < 4; ++e) { st[e] = st[e] * w0_[e] + sa * b0[e] + vi * k0[e]; st[4 + e] = st[4 + e] * w1_[e] + sa * b1[e] + vi * k1[e]; }
                float y = (st[0] * r0[0] + st[1] * r0[1]) + (st[2] * r0[2] + st[3] * r0[3]) + (st[4] * r1[0] + st[5] * r1[1]) + (st[6] * r1[2] + st[7] * r1[3]);
                y = red8(y);
                if ((tid & 7) == 0) LY[t * 64 + i] = y;
            }
        }
        __syncthreads();
        {
            float y[8], s = 0.f, q = 0.f, bon = 0.f, g[8], z[8], f[8];
#pragma unroll
            for (int e = 0; e < 8; ++e) { y[e] = LY[tok * 64 + 8 * cg + e]; s += y[e]; }
            const float mean = red8(s) * (1.0f / 64.0f);
#pragma unroll
            for (int e = 0; e < 8; ++e) { y[e] -= mean; q += y[e] * y[e]; bon += LR[tok * 64 + 8 * cg + e] * LK[tok * 64 + 8 * cg + e] * rkv[e]; }
            const float rstd = 1.0f / sqrtf(red8(q) * (1.0f / 64.0f) + LNX_EPS); bon = red8(bon);
            unpack8(*(const GAS v4u*)(XL + m * 3072 + 2048 + ch0), g); unpack8(*(const GAS v4u*)(SC + m * 1024 + ch0), z);
#pragma unroll
            for (int e = 0; e < 8; ++e) f[e] = (y[e] * rstd * lg[e] + lb[e] + bon * LV[tok * 64 + 8 * cg + e]) * g[e] * z[e];
            *(GAS v4u*)(MIX + m * 2048 + 1024 + ch0) = pack8(f);
        }
        __syncthreads();
    }
}
__device__ __forceinline__ void final_norm_phase(Frame& F) {
    const float* ssq = (const float*)(F.ws + WS_SSQ);
    const int gw = F.vcu * NWAVES + F.wave, NGW = F.G * NWAVES;
    for (int m = gw; m < M; m += NGW) {
        float sv = (F.lane < 32) ? ssq[(size_t)m * 32 + F.lane] : 0.f; sv = wave_sum(sv);
        const float rs = 1.0f / sqrtf(sv * (1.0f / DM) + NORM_EPS);
        GAS f32x4* yr = (GAS f32x4*)(F.out + (size_t)m * DM) + F.lane; const GAS f32x4* gr = (const GAS f32x4*)F.final_g + F.lane;
#pragma unroll
        for (int j = 0; j < 8; ++j) { const f32x4 v = yr[64 * j], g = gr[64 * j]; yr[64 * j] = v * rs * g; }
    }
}


constexpr size_t WS_PB = WS_SA;
constexpr size_t WS_QB = WS_SA + 32 * MiB;
constexpr size_t WS_GB = WS_SA + 64 * MiB;
constexpr size_t WS_YB = WS_SA + 96 * MiB;
constexpr size_t WS_HB = 465 * MiB;
constexpr int RW_PB = 144;
constexpr int RW_TA = 0, RW_TB = 9216, RW_TK = 18432, RW_TR = 27648, RW_TV = 36864, RW_MRB = 46080, RW_LAK = 55296, RW_MRK = 64512, RW_XT = 55296  ,
              RW_CL = 55296  , RW_LABF = 73728  , RW_TOT = 73728  , RW_L21 = 81920  ,
              RW_TT = 84480  , RW_R2T = 89600, RW_GC = 98816;
constexpr int RW_PS = 80;

struct RwElem { float r[8], kp[8], v[8], as[8], kn[8], lw[8]; };
__device__ __forceinline__ void rwkv_elem(const Frame& F, const bf16* SB, const bf16* XL, size_t m, bool first, int ch0, RwElem& E) {
    float pr[8], pk[8], pv[8], xw[8], xa[8], k[8];
    unpack8(*(const GAS v4u*)(SB + m * 3072 + ch0), E.r); unpack8(*(const GAS v4u*)(SB + m * 3072 + 1024 + ch0), k); unpack8(*(const GAS v4u*)(SB + m * 3072 + 2048 + ch0), E.v);
    if (!first) { unpack8(*(const GAS v4u*)(SB + (m - 1) * 3072 + ch0), pr); unpack8(*(const GAS v4u*)(SB + (m - 1) * 3072 + 1024 + ch0), pk); unpack8(*(const GAS v4u*)(SB + (m - 1) * 3072 + 2048 + ch0), pv); }
    else {
#pragma unroll
        for (int e = 0; e < 8; ++e) { pr[e] = 0.f; pk[e] = 0.f; pv[e] = 0.f; } }
    unpack8(*(const GAS v4u*)(XL + m * 3072 + ch0), xw); unpack8(*(const GAS v4u*)(XL + m * 3072 + 1024 + ch0), xa);
    float ss = 0.f, kk[8];
#pragma unroll
    for (int e = 0; e < 8; ++e) { const int ch = ch0 + e;
        E.r[e] += (pr[e] - E.r[e]) * F.shift_mu[ch]; k[e] += (pk[e] - k[e]) * F.shift_mu[1024 + ch]; E.v[e] += (pv[e] - E.v[e]) * F.shift_mu[2048 + ch];
        E.as[e] = sigmoidf_(F.a0[ch] + xa[e]); kk[e] = k[e] * F.k_k[ch]; ss += kk[e] * kk[e];
        E.lw[e] = -0.6065306597126334f * sigmoidf_(F.w0[ch] + xw[e]); E.kp[e] = k[e] * (1.0f + (E.as[e] - 1.0f) * F.k_a[ch]); }
    ss = red8(ss); const float inv = 1.0f / fmaxf(sqrtf(ss), 1e-12f);
#pragma unroll
    for (int e = 0; e < 8; ++e) E.kn[e] = kk[e] * inv;
}
__device__ __forceinline__ bf16x8 rw_row(const LAS unsigned char* tile, int pitch, int row0, int k0, int lane) {
    return *(const LAS bf16x8*)(tile + (row0 + (lane & 31)) * pitch + (k0 + 8 * (lane >> 5)) * 2); }
__device__ __forceinline__ bf16x8 rw_tr(const LAS unsigned char* tile, int pitch, int k0, int n0, int lane) {
    const LAS unsigned char* p = tile + (k0 + 8 * (lane >> 5) + ((lane & 15) >> 2)) * pitch + (n0 + 16 * ((lane >> 4) & 1) + 4 * (lane & 3)) * 2;
    const s16x4 lo = vtr(p), hi = vtr(p + 4 * pitch);
    return (bf16x8){lo[0], lo[1], lo[2], lo[3], hi[0], hi[1], hi[2], hi[3]}; }
#define RW_MFMA(a, b, c) __builtin_amdgcn_mfma_f32_32x32x16_bf16((a), (b), (c), 0, 0, 0)
__device__ __forceinline__ void rw_st_lr(LAS unsigned char* tile, int pitch, int row, int col0, const f32x16& v, int h) {
#pragma unroll
    for (int q = 0; q < 4; ++q) { u32x2 w; w.x = pk2(v[4 * q], v[4 * q + 1]); w.y = pk2(v[4 * q + 2], v[4 * q + 3]); *(LAS u32x2*)(tile + row * pitch + (col0 + 8 * q + 4 * h) * 2) = w; }
}
__device__ __forceinline__ void rw_st_lr_g(bf16* base, int pitch_el, int row, int col0, const f32x16& v, int h) {
#pragma unroll
    for (int q = 0; q < 4; ++q) { u32x2 w; w.x = pk2(v[4 * q], v[4 * q + 1]); w.y = pk2(v[4 * q + 2], v[4 * q + 3]); *(GAS u32x2*)(base + (size_t)row * pitch_el + col0 + 8 * q + 4 * h) = w; }
}


__device__ __attribute__((noinline)) void rw_inv32(const LAS float* Lb, LAS unsigned char* dst, int x31) {
    float Tr[32];
#pragma unroll
    for (int u = 0; u < 32; ++u) Tr[u] = (u == x31) ? 1.f : 0.f;
#pragma unroll
    for (int s = 30; s >= 0; --s) {
        float a0 = 0.f, a1 = 0.f, a2 = 0.f, a3 = 0.f;
#pragma unroll
        for (int c4 = (s + 1) >> 2; c4 < 8; ++c4) { const f32x4 lv = *(const LAS f32x4*)(Lb + s * 32 + 4 * c4);
            if (4 * c4 + 0 > s) a0 += Tr[4 * c4 + 0] * lv[0];
            if (4 * c4 + 1 > s) a1 += Tr[4 * c4 + 1] * lv[1];
            if (4 * c4 + 2 > s) a2 += Tr[4 * c4 + 2] * lv[2];
            if (4 * c4 + 3 > s) a3 += Tr[4 * c4 + 3] * lv[3]; }
        const float val = (a0 + a1) + (a2 + a3);
        Tr[s] = (s < x31) ? val : Tr[s];
    }
#pragma unroll
    for (int c8 = 0; c8 < 4; ++c8) { float f[8];
#pragma unroll
        for (int e = 0; e < 8; ++e) f[e] = Tr[8 * c8 + e];
        *(LAS v4u*)(dst + c8 * 16) = pack8(f); }
}
__device__ __forceinline__ void rwkv_chunk_unit(Frame& F, int unit) {
    LAS unsigned char* L = F.lds; const int tid = F.tid, lane = F.lane, wave = F.wave, x31 = lane & 31, h = lane >> 5;
    const int bh = unit >> 7, c = unit & 127, b = bh >> 4, hd = bh & 15;
    const bf16* SB = (const bf16*)(F.ws + WS_SB); const bf16* XL = (const bf16*)(F.ws + WS_XL);
#ifndef RWDBL
#define RWDBL 0
#endif
    for (int rep_ = 0; rep_ < 1 + ((RWDBL >> 0) & 1); ++rep_) {
        if (rep_) __syncthreads();
        const int tok = tid >> 3, cg = tid & 7, ch0 = hd * 64 + 8 * cg; const size_t m = (size_t)b * SEQ + c * 64 + tok;
        RwElem E; rwkv_elem(F, SB, XL, m, (c * 64 + tok) == 0, ch0, E);
        LAS float* CL = (LAS float*)(L + RW_CL); LAS float* TOT = (LAS float*)(L + RW_TOT);
        *(LAS f32x4*)(CL + tok * 64 + 8 * cg) = (f32x4){E.lw[0], E.lw[1], E.lw[2], E.lw[3]}; *(LAS f32x4*)(CL + tok * 64 + 8 * cg + 4) = (f32x4){E.lw[4], E.lw[5], E.lw[6], E.lw[7]};
        __syncthreads();
        { const int j = tid & 63, tg = tid >> 6; float p[8], run = 0.f;
#pragma unroll
          for (int e = 0; e < 8; ++e) { run += CL[(8 * tg + e) * 64 + j]; p[e] = run; }
          TOT[tg * 64 + j] = run;
          __syncthreads();
          float off = 0.f;
#pragma unroll
          for (int g = 0; g < 7; ++g) off += (g < tg) ? TOT[g * 64 + j] : 0.f;
#pragma unroll
          for (int e = 0; e < 8; ++e) CL[(8 * tg + e) * 64 + j] = p[e] + off; }
        __syncthreads();
        const f32x4 c0 = *(const LAS f32x4*)(CL + tok * 64 + 8 * cg), c1 = *(const LAS f32x4*)(CL + tok * 64 + 8 * cg + 4);
        float fa[8], fr[8], fb[8], fk[8];
#pragma unroll
        for (int e = 0; e < 8; ++e) { const float cl = e < 4 ? c0[e] : c1[e - 4]; const float ep = __expf(cl), en = __expf(-cl), ea = __expf(cl - E.lw[e]);
            fa[e] = -E.kn[e] * ea; fr[e] = E.r[e] * ep; fb[e] = E.kn[e] * E.as[e] * en; fk[e] = E.kp[e] * en;
            if (tok == 63) ((LAS float*)(L + RW_GC))[8 * cg + e] = ep; }
        const int o = tok * RW_PB + cg * 16;
        *(LAS v4u*)(L + RW_TA + o) = pack8(fa); *(LAS v4u*)(L + RW_TR + o) = pack8(fr); *(LAS v4u*)(L + RW_TB + o) = pack8(fb); *(LAS v4u*)(L + RW_TK + o) = pack8(fk); *(LAS v4u*)(L + RW_TV + o) = pack8(E.v);
    }
    __syncthreads();
    for (int rep_ = 0; rep_ < 1 + ((RWDBL >> 1) & 1); ++rep_)
    for (int ti = wave; ti < 12; ti += 8) {
        const int prod = ti / 3, tt = ti % 3, sh = tt == 2 ? 1 : 0, th = tt == 0 ? 0 : 1;
        const LAS unsigned char* Bm = L + ((prod & 1) ? RW_TK : RW_TB); const LAS unsigned char* Am = L + ((prod & 2) ? RW_TR : RW_TA);
        f32x16 acc = {};
#pragma unroll
        for (int ks = 0; ks < 4; ++ks) acc = RW_MFMA(rw_row(Bm, RW_PB, 32 * sh, 16 * ks, lane), rw_row(Am, RW_PB, 32 * th, 16 * ks, lane), acc);
        if (sh == th) {
            const bool strict = prod < 2;
#pragma unroll
            for (int i = 0; i < 16; ++i) { const int s = crow(i, h); if (strict ? (s >= x31) : (s > x31)) acc[i] = 0.f; }
        }
        if (prod == 0) {
            if (sh == th) { LAS float* LF = (LAS float*)(L + RW_LABF) + sh * 1024;
#pragma unroll
                for (int i = 0; i < 16; ++i) LF[crow(i, h) * 32 + x31] = acc[i]; }
            else rw_st_lr(L + RW_L21, RW_PS, x31, 0, acc, h);
        } else rw_st_lr(L + (prod == 1 ? RW_LAK : prod == 2 ? RW_MRB : RW_MRK), RW_PB, 32 * th + x31, 32 * sh, acc, h);
    }
    __syncthreads();
    f32x16 keepQ = {}, keepY = {};
    for (int rep_ = 0; rep_ < 1 + ((RWDBL >> 2) & 1); ++rep_) {
    keepQ = f32x16{}; keepY = f32x16{};
    if (wave == 0) {
        rw_inv32((const LAS float*)(L + RW_LABF) + h * 1024, L + RW_TT + (32 * h + x31) * RW_PS, x31);
    } else if (wave < 4) {
        for (int ti = wave - 1; ti < 4; ti += 3) { const int th = ti >> 1, ih = ti & 1;
            f32x16 acc = {};
            for (int ks = 0; ks < 2 * (th + 1); ++ks) acc = RW_MFMA(rw_row(L + RW_LAK, RW_PB, 32 * th, 16 * ks, lane), rw_tr(L + RW_TV, RW_PB, 16 * ks, 32 * ih, lane), acc);
            rw_st_lr(L + RW_R2T, RW_PB, 32 * ih + x31, 32 * th, acc, h); }
    } else {
        const int w4 = wave - 4, hi2 = w4 >> 1, lo2 = w4 & 1;
#pragma unroll
        for (int ks = 0; ks < 4; ++ks) keepQ = RW_MFMA(rw_tr(L + RW_TK, RW_PB, 16 * ks, 32 * hi2, lane), rw_tr(L + RW_TV, RW_PB, 16 * ks, 32 * lo2, lane), keepQ);
        for (int ks = 0; ks < 2 * (lo2 + 1); ++ks) keepY = RW_MFMA(rw_tr(L + RW_TV, RW_PB, 16 * ks, 32 * hi2, lane), rw_row(L + RW_MRK, RW_PB, 32 * lo2, 16 * ks, lane), keepY);
    }
    }
    __syncthreads();
    for (int rep_ = 0; rep_ < 1 + ((RWDBL >> 3) & 1); ++rep_) {
    if (rep_) __syncthreads();
    if (wave < 4) { const int nh = wave;
        f32x16 acc = {};
#pragma unroll
        for (int ks = 0; ks < 2; ++ks) { const bf16x8 af = rw_row(L + RW_TT, RW_PS, 0, 16 * ks, lane);
            const bf16x8 bfr = nh < 2 ? rw_tr(L + RW_TA, RW_PB, 16 * ks, 32 * nh, lane) : rw_row(L + RW_R2T, RW_PB, 32 * (nh - 2), 16 * ks, lane);
            acc = RW_MFMA(af, bfr, acc); }
        rw_st_lr(L + RW_XT, RW_PB, 32 * nh + x31, 0, acc, h);
    }
    __syncthreads();
    if (wave < 4) { const int nh = wave;
        f32x16 z = {};
#pragma unroll
        for (int ks = 0; ks < 2; ++ks) z = RW_MFMA(rw_row(L + RW_L21, RW_PS, 0, 16 * ks, lane), rw_row(L + RW_XT, RW_PB, 32 * nh, 16 * ks, lane), z);
        f32x16 acc = {};
#pragma unroll
        for (int ks = 0; ks < 2; ++ks) { const bf16x8 af = rw_row(L + RW_TT, RW_PS, 32, 16 * ks, lane);
            const bf16x8 bfr = nh < 2 ? rw_tr(L + RW_TA, RW_PB, 32 + 16 * ks, 32 * nh, lane) : rw_row(L + RW_R2T, RW_PB, 32 * (nh - 2), 32 + 16 * ks, lane);
            acc = RW_MFMA(af, bfr, acc); }
#pragma unroll
        for (int ks = 0; ks < 2; ++ks) {
            const LAS unsigned char* tp = L + RW_TT + (32 + x31) * RW_PS + (16 * ks + 4 * h) * 2;
            const u32x2 t0 = *(const LAS u32x2*)tp, t1 = *(const LAS u32x2*)(tp + 16);
            const v4u aw = {t0.x, t0.y, t1.x, t1.y};
            v4u zw; zw.x = pk2(z[8 * ks + 0], z[8 * ks + 1]); zw.y = pk2(z[8 * ks + 2], z[8 * ks + 3]); zw.z = pk2(z[8 * ks + 4], z[8 * ks + 5]); zw.w = pk2(z[8 * ks + 6], z[8 * ks + 7]);
            acc = RW_MFMA(__builtin_bit_cast(bf16x8, aw), __builtin_bit_cast(bf16x8, zw), acc); }
        rw_st_lr(L + RW_XT, RW_PB, 32 * nh + x31, 32, acc, h);
    }
    }
    __syncthreads();
    const LAS float* GC = (const LAS float*)(L + RW_GC);
    for (int rep_ = 0; rep_ < 1 + ((RWDBL >> 4) & 1); ++rep_) {
    f32x16 accQ = keepQ, accY = keepY;
    if (wave < 4) {
        { const int j2h = wave >> 1, jh = wave & 1;
          f32x16 acc = {};
#pragma unroll
          for (int ks = 0; ks < 4; ++ks) acc = RW_MFMA(rw_row(L + RW_XT, RW_PB, 32 * j2h, 16 * ks, lane), rw_tr(L + RW_TB, RW_PB, 16 * ks, 32 * jh, lane), acc);
          const float g = GC[32 * jh + x31];
          bf16* Pg = (bf16*)(F.ws + WS_PB) + (size_t)unit * 4096 + (size_t)(32 * jh + x31) * 64 + 32 * j2h;
#pragma unroll
          for (int q = 0; q < 4; ++q) { float v[4];
#pragma unroll
              for (int e = 0; e < 4; ++e) { const int j2 = 32 * j2h + 8 * q + 4 * h + e; v[e] = g * (acc[4 * q + e] + ((j2 == 32 * jh + x31) ? 1.f : 0.f)); }
              const int off = 8 * q + 4 * h, pos = 8 * ((off & 15) >> 2) + 4 * (off >> 4);
              u32x2 w; w.x = pk2(v[0], v[1]); w.y = pk2(v[2], v[3]); *(GAS u32x2*)(Pg + pos) = w; } }
        { const int jh = wave >> 1, th = wave & 1;
          f32x16 acc = {};
          for (int ks = 0; ks < 2 * (th + 1); ++ks) acc = RW_MFMA(rw_row(L + RW_XT, RW_PB, 32 * jh, 16 * ks, lane), rw_row(L + RW_MRB, RW_PB, 32 * th, 16 * ks, lane), acc);
#pragma unroll
          for (int q = 0; q < 4; ++q) { const u32x2 rr = *(const LAS u32x2*)(L + RW_TR + (32 * th + x31) * RW_PB + (32 * jh + 8 * q + 4 * h) * 2);
              acc[4 * q] += bflo(rr.x); acc[4 * q + 1] += bfhi(rr.x); acc[4 * q + 2] += bflo(rr.y); acc[4 * q + 3] += bfhi(rr.y); }
          rw_st_lr_g((bf16*)(F.ws + WS_GB) + (size_t)unit * 4096, 64, 32 * th + x31, 32 * jh, acc, h); }
    } else {
        const int w4 = wave - 4, hi2 = w4 >> 1, lo2 = w4 & 1;
        {
#pragma unroll
          for (int ks = 0; ks < 4; ++ks) accQ = RW_MFMA(rw_tr(L + RW_TB, RW_PB, 16 * ks, 32 * hi2, lane), rw_row(L + RW_XT, RW_PB, 64 + 32 * lo2, 16 * ks, lane), accQ);
#pragma unroll
          for (int i = 0; i < 16; ++i) accQ[i] *= GC[32 * hi2 + crow(i, h)];
          rw_st_lr_g((bf16*)(F.ws + WS_QB) + (size_t)unit * 4096, 64, 32 * lo2 + x31, 32 * hi2, accQ, h); }
        {
          for (int ks = 0; ks < 2 * (lo2 + 1); ++ks) accY = RW_MFMA(rw_row(L + RW_XT, RW_PB, 64 + 32 * hi2, 16 * ks, lane), rw_row(L + RW_MRB, RW_PB, 32 * lo2, 16 * ks, lane), accY);
          rw_st_lr_g((bf16*)(F.ws + WS_YB) + (size_t)unit * 4096, 64, 32 * lo2 + x31, 32 * hi2, accY, h); }
    }
    }
    __syncthreads();
}
__device__ __forceinline__ void rwkv_chunk_phase(Frame& F) {
    for (int u = F.vcu; u < BATCH * NH * 128; u += F.G) rwkv_chunk_unit(F, u);
}

typedef float f32x4_t __attribute__((ext_vector_type(4)));
__device__ __forceinline__ void rwkv_scan_phase(Frame& F) {
    if (F.vcu >= BATCH * NH * 4 || F.wave != 0) return;
    const int bh = F.vcu >> 2, isl = F.vcu & 3, lane = F.lane, i16 = lane & 15, jg = lane >> 4;
    const bf16* PBf = (const bf16*)(F.ws + WS_PB) + (size_t)bh * 128 * 4096;
    const bf16* QBf = (const bf16*)(F.ws + WS_QB) + (size_t)bh * 128 * 4096 + (size_t)(16 * isl + i16) * 64 + 4 * jg;
    bf16* HBf = (bf16*)(F.ws + WS_HB) + (size_t)bh * 128 * 4096 + (size_t)(16 * isl + i16) * 64 + 4 * jg;
    f32x4_t hacc[4];
#pragma unroll
    for (int mt = 0; mt < 4; ++mt) hacc[mt] = (f32x4_t){0.f, 0.f, 0.f, 0.f};
    constexpr int DEPTH = 4;
    v4u pf[DEPTH][4][2]; u32x2 qf[DEPTH][4];
#pragma unroll
    for (int d = 0; d < DEPTH; ++d)
#pragma unroll
        for (int mt = 0; mt < 4; ++mt) { qf[d][mt] = *(const GAS u32x2*)(QBf + (size_t)d * 4096 + 16 * mt);
#pragma unroll
            for (int st = 0; st < 2; ++st) pf[d][mt][st] = *(const GAS v4u*)(PBf + (size_t)d * 4096 + (size_t)(16 * mt + i16) * 64 + 32 * st + 8 * jg); }
    for (int cc = 0; cc < 128; cc += DEPTH) {
#pragma unroll
        for (int d = 0; d < DEPTH; ++d) { const int c = cc + d;
            v4u hb[2];
#pragma unroll
            for (int mt = 0; mt < 4; ++mt) { u32x2 w; w.x = pk2(hacc[mt][0], hacc[mt][1]); w.y = pk2(hacc[mt][2], hacc[mt][3]);
                *(GAS u32x2*)(HBf + (size_t)c * 4096 + 16 * mt) = w;
                if (mt & 1) { hb[mt >> 1].z = w.x; hb[mt >> 1].w = w.y; } else { hb[mt >> 1].x = w.x; hb[mt >> 1].y = w.y; } }
#pragma unroll
            for (int mt = 0; mt < 4; ++mt) {
                f32x4_t a = {bflo(qf[d][mt].x), bfhi(qf[d][mt].x), bflo(qf[d][mt].y), bfhi(qf[d][mt].y)};
#pragma unroll
                for (int st = 0; st < 2; ++st) a = __builtin_amdgcn_mfma_f32_16x16x32_bf16(__builtin_bit_cast(bf16x8, pf[d][mt][st]), __builtin_bit_cast(bf16x8, hb[st]), a, 0, 0, 0);
                hacc[mt] = a;
            }
            if (c + DEPTH < 128) {
#pragma unroll
                for (int mt = 0; mt < 4; ++mt) { qf[d][mt] = *(const GAS u32x2*)(QBf + (size_t)(c + DEPTH) * 4096 + 16 * mt);
#pragma unroll
                    for (int st = 0; st < 2; ++st) pf[d][mt][st] = *(const GAS v4u*)(PBf + (size_t)(c + DEPTH) * 4096 + (size_t)(16 * mt + i16) * 64 + 32 * st + 8 * jg); }
            }
        }
    }
}

constexpr int RWC_WLDS = 32 * 272;
__device__ __forceinline__ void rwkv_out_phase(Frame& F) {
    const int lane = F.lane, x31 = lane & 31, h = lane >> 5;
    LAS unsigned char* wl = F.lds + F.wave * RWC_WLDS;
    const bf16* SB = (const bf16*)(F.ws + WS_SB); const bf16* SC = (const bf16*)(F.ws + WS_SC); const bf16* XL = (const bf16*)(F.ws + WS_XL); bf16* MIX = (bf16*)(F.ws + WS_MIX);
    const int gw = F.vcu * NWAVES + F.wave, NGW = F.G * NWAVES;
    for (int it = gw; it < BATCH * NH * 128 * 2; it += NGW) {
        const int unit = it >> 1, th = it & 1, bh = unit >> 7, c = unit & 127, b = bh >> 4, hd = bh & 15;
        const bf16* Hg = (const bf16*)(F.ws + WS_HB) + (size_t)unit * 4096; const bf16* Gg = (const bf16*)(F.ws + WS_GB) + (size_t)unit * 4096; const bf16* Yg = (const bf16*)(F.ws + WS_YB) + (size_t)unit * 4096;
        f32x16 y[2];
#pragma unroll
        for (int ih = 0; ih < 2; ++ih) {
#pragma unroll
            for (int q = 0; q < 4; ++q) { const u32x2 w = *(const GAS u32x2*)(Yg + (size_t)(32 * th + x31) * 64 + 32 * ih + 8 * q + 4 * h);
                y[ih][4 * q] = bflo(w.x); y[ih][4 * q + 1] = bfhi(w.x); y[ih][4 * q + 2] = bflo(w.y); y[ih][4 * q + 3] = bfhi(w.y); }
#pragma unroll
            for (int ks = 0; ks < 4; ++ks) { const bf16x8 af = *(const GAS bf16x8*)(Hg + (size_t)(32 * ih + x31) * 64 + 16 * ks + 8 * h), bfr = *(const GAS bf16x8*)(Gg + (size_t)(32 * th + x31) * 64 + 16 * ks + 8 * h);
                y[ih] = RW_MFMA(af, bfr, y[ih]); }
        }
        float s = 0.f;
#pragma unroll
        for (int ih = 0; ih < 2; ++ih)
#pragma unroll
            for (int i = 0; i < 16; ++i) s += y[ih][i];
        s += __shfl_xor(s, 32); const float mean = s * (1.0f / 64.0f); float q2 = 0.f;
#pragma unroll
        for (int ih = 0; ih < 2; ++ih)
#pragma unroll
            for (int i = 0; i < 16; ++i) { y[ih][i] -= mean; q2 += y[ih][i] * y[ih][i]; }
        q2 += __shfl_xor(q2, 32); const float rstd = 1.0f / sqrtf(q2 * (1.0f / 64.0f) + LNX_EPS);
#pragma unroll
        for (int ih = 0; ih < 2; ++ih)
#pragma unroll
            for (int q = 0; q < 4; ++q) *(LAS f32x4*)(wl + x31 * 272 + (32 * ih + 8 * q + 4 * h) * 4) = (f32x4){y[ih][4 * q] * rstd, y[ih][4 * q + 1] * rstd, y[ih][4 * q + 2] * rstd, y[ih][4 * q + 3] * rstd};
        LDS_WAIT(); asm volatile("" ::: "memory");
#pragma unroll 1
        for (int ps = 0; ps < 4; ++ps) { const int tok = 8 * ps + (lane >> 3), cg = lane & 7, ch0 = hd * 64 + 8 * cg; const size_t m = (size_t)b * SEQ + c * 64 + 32 * th + tok;
            RwElem E; rwkv_elem(F, SB, XL, m, (c * 64 + 32 * th + tok) == 0, ch0, E);
            float bon = 0.f, g[8], z[8], f[8];
#pragma unroll
            for (int e = 0; e < 8; ++e) bon += E.r[e] * E.kp[e] * F.r_k[ch0 + e];
            bon = red8(bon);
            unpack8(*(const GAS v4u*)(XL + m * 3072 + 2048 + ch0), g); unpack8(*(const GAS v4u*)(SC + m * 1024 + ch0), z);
            const f32x4 y0 = *(const LAS f32x4*)(wl + tok * 272 + cg * 32), y1 = *(const LAS f32x4*)(wl + tok * 272 + cg * 32 + 16);
#pragma unroll
            for (int e = 0; e < 8; ++e) { const float yn = e < 4 ? y0[e] : y1[e - 4]; f[e] = (yn * F.lnx_g[ch0 + e] + F.lnx_b[ch0 + e] + bon * E.v[e]) * g[e] * z[e]; }
            *(GAS v4u*)(MIX + m * 2048 + 1024 + ch0) = pack8(f); }
        LDS_WAIT(); asm volatile("" ::: "memory");
    }
}
struct Args { const float* in[16]; float* out; unsigned char* ws; int ph_lo, ph_hi, li, pad; };
__global__ void __launch_bounds__(NWAVES * 64, 2) hymba_fwd(Args args) {
    extern __shared__ __attribute__((aligned(16))) unsigned char lds[];
    Frame F;
    F.lds = (LAS unsigned char*)lds;
    F.tid = threadIdx.x; F.lane = F.tid & 63; F.wave = __builtin_amdgcn_readfirstlane(F.tid >> 6);
    F.G = gridDim.x; { const int bx = blockIdx.x; F.vcu = (F.G % 8 == 0) ? (bx % 8) * (F.G / 8) + bx / 8 : bx; }
    F.x = args.in[0]; F.norm_g = args.in[1]; F.w_in = args.in[2]; F.shift_mu = args.in[3]; F.w0 = args.in[4]; F.w2 = args.in[5]; F.a0 = args.in[6]; F.a2 = args.in[7]; F.g2 = args.in[8];
    F.k_k = args.in[9]; F.k_a = args.in[10]; F.r_k = args.in[11]; F.lnx_g = args.in[12]; F.lnx_b = args.in[13]; F.w_out = args.in[14]; F.final_g = args.in[15];
    F.out = args.out; F.ws = args.ws;
    volatile LAS unsigned* MISC = (volatile LAS unsigned*)(F.lds + MISC_OFF);
    for (int u = F.tid; u < (LDS_BYTES - LDSCTL_OFF) / 4; u += NWAVES * 64) ((LAS unsigned*)(F.lds + LDSCTL_OFF))[u] = 0u;
    __syncthreads();
    gu32* ctl = (gu32*)(F.ws + WS_CTL);
    XcdBarrier bar; bar.bar = (unsigned*)(ctl + CW_BAR); bar.x = 0; bar.st = nullptr;
    if (N_LAUNCHES != NPHASE) bar = xcd_barrier_post((unsigned*)(ctl + CW_BAR) + args.li * XCD_BAR_WORDS, MISC + 8);
    const int lo = args.ph_lo, hi = args.ph_hi;
#ifndef PHMASK
#define PHMASK 0x3ff
#endif
#ifndef RWKV_SEQ
#define RWKV_SEQ 0
#endif
#ifndef PROBE_MASK
#define PROBE_MASK 0
#endif
#define IN(k) (((pmask >> (k)) & 1u) && lo <= (k) && (k) < hi)
#define SEAM(k) do { if (lo <= (k) && (k) + 1 < hi) xcd_barrier(bar); } while (0)
#ifndef DOUBLE_MASK
#define DOUBLE_MASK 0
#endif
#define PH0 p0_prologue(F);
#define PH1 { pg8::Gemm g{(const pg8::bf16_t*)(F.ws + WS_XN), (const pg8::bf16_t*)(F.ws + WS_BT1), M, N1, DM + args.pad}; pg8::StaticOrder S; S.init(M, N1, F.G, (int)blockIdx.x); \
        EpiProj E{(pg8::bf16_t*)(F.ws + WS_SA), (pg8::bf16_t*)(F.ws + WS_SB), (pg8::bf16_t*)(F.ws + WS_SC), (pg8::bf16_t*)(F.ws + WS_SD), (const float*)(F.ws + WS_COS), (const float*)(F.ws + WS_SIN)}; \
        pg8::gemm_phase<EpiProj, pg8::StaticOrder, true, true>(F.lds, g, S, E); }
#define PH2 { attn_phase(F); lora_act_phase(F); }
#define PH3 combine_phase(F);
#define PH4 { pg8::Gemm g{(const pg8::bf16_t*)(F.ws + WS_AL), (const pg8::bf16_t*)(F.ws + WS_BTL), M, NLORA, KLORA + args.pad}; pg8::StaticOrder S; S.init(M, NLORA, F.G, (int)blockIdx.x); \
        pg8::EpiBf16<0> E{(pg8::bf16_t*)(F.ws + WS_XL), NLORA, nullptr, 0, 0, 1.f}; \
        pg8::gemm_phase<pg8::EpiBf16<0>, pg8::StaticOrder, true, true>(F.lds, g, S, E); }
#define PH5 { if (RWKV_SEQ) rwkv_seq_phase(F); else rwkv_chunk_phase(F); }
#define PH6 { if (!RWKV_SEQ) rwkv_scan_phase(F); }
#define PH7 { if (!RWKV_SEQ) rwkv_out_phase(F); }
#define PH8 { pg8::Gemm g{(const pg8::bf16_t*)(F.ws + WS_MIX), (const pg8::bf16_t*)(F.ws + WS_BT2), M, DM, DM + args.pad}; pg8::StaticOrder S; S.init(M, DM, F.G, (int)blockIdx.x); \
        EpiOut E{F.x, F.out, (float*)(F.ws + WS_SSQ)}; \
        pg8::gemm_phase<EpiOut, pg8::StaticOrder, true, true>(F.lds, g, S, E); }
#define PH9 final_norm_phase(F);
#define RUN(k, BODY) if (IN(k)) { BODY if ((DOUBLE_MASK >> (k)) & 1) { xcd_barrier(bar); BODY } } SEAM(k);
#define PHASE_PROGRAM() RUN(0, PH0) RUN(1, PH1) RUN(2, PH2) RUN(3, PH3) RUN(4, PH4) RUN(5, PH5) RUN(6, PH6) RUN(7, PH7) RUN(8, PH8) RUN(9, PH9)
    if (PROBE_MASK) { const unsigned pmask = (unsigned)(PROBE_MASK); PHASE_PROGRAM() xcd_barrier(bar); }
    { const unsigned pmask = (unsigned)(PHMASK); PHASE_PROGRAM() }
#undef PHASE_PROGRAM
#undef IN
#undef SEAM
}

extern "C" void kernel_launch(void* const* d_in, const int* in_sizes, int n_in, void* d_out, int out_size, void* d_ws, size_t ws_size, hipStream_t stream) {
    static int grid = 0;
    if (grid == 0) {
        if (n_in != 16 || in_sizes[0] != M * DM || out_size != M * DM || ws_size < WS_END) { fprintf(stderr, "kernel_launch: unexpected shapes (n_in %d, in0 %d, out %d, ws %zu)\n", n_in, n_in > 0 ? in_sizes[0] : -1, out_size, ws_size); grid = -1; return; }
        int dev = 0, cus = 0, per_cu = 0;
        if (hipGetDevice(&dev) != hipSuccess || hipDeviceGetAttribute(&cus, hipDeviceAttributeMultiprocessorCount, dev) != hipSuccess) { grid = -1; return; }
        if (hipFuncSetAttribute((const void*)hymba_fwd, hipFuncAttributeMaxDynamicSharedMemorySize, LDS_BYTES) != hipSuccess) { grid = -1; return; }
        if (hipOccupancyMaxActiveBlocksPerMultiprocessor(&per_cu, (const void*)hymba_fwd, NWAVES * 64, LDS_BYTES) != hipSuccess || per_cu < 1) { fprintf(stderr, "kernel_launch: occupancy query says %d blocks per CU\n", per_cu); grid = -1; return; }
        (void)hipGetLastError();
        grid = cus;
    }
    if (grid < 0) return;
    if (hipMemsetAsync((char*)d_ws + WS_CTL, 0, CTL_ZERO_BYTES, stream) != hipSuccess) return;
    Args a{};
    for (int i = 0; i < 16; ++i) a.in[i] = (const float*)d_in[i];
    a.out = (float*)d_out; a.ws = (unsigned char*)d_ws;
    if (N_LAUNCHES == 1) { a.ph_lo = 0; a.ph_hi = NPHASE; a.li = 0; hipLaunchKernelGGL(hymba_fwd, dim3(grid), dim3(NWAVES * 64), LDS_BYTES, stream, a); }
    else for (int li = 0; li < NPHASE; ++li) { a.ph_lo = li; a.ph_hi = li + 1; a.li = 0; hipLaunchKernelGGL(hymba_fwd, dim3(grid), dim3(NWAVES * 64), LDS_BYTES, stream, a); }
}
```
